# Optimizing an MI355X kernel written in HIP

```python
import math
import jax, jax.numpy as jnp
from jax import lax
import numpy as np

D_MODEL = 1024
BATCH = 4
SEQ = 8192
DEPTH = 1
DEC_BATCH = 4
DEC_SEQ = 4096
PAST_LEN = 128

EPS = 1e-6
ROPE_THETA = 10000.0
BLOCK = 128
WINDOW = 128
HA = 8
KVA = 2
GA = HA // KVA
DA = 64
HB = 8
Q_RANK = 384
KV_RANK = 256
DN = 64
DR = 32
DV = 64
SPLIT_SIZES = (HA * DA, KVA * DA, KVA * DA, Q_RANK, KV_RANK, DR)
D_IN = sum(SPLIT_SIZES)
D_MIX = HA * DA + HB * DV
D_FF = int(math.ceil(8 * D_MODEL / 3 / 256) * 256)
NEG = -1e30

kernel_name = "hymba_swa_sink_mla_encoder"


def rms_norm(x, g):
    xf = x.astype(jnp.float32)
    y = xf * lax.rsqrt(jnp.mean(xf * xf, axis=-1, keepdims=True) + EPS)
    return (y * g.astype(jnp.float32)).astype(x.dtype)


def rope_tables(seq, dim):
    inv = 1.0 / (ROPE_THETA ** (jnp.arange(0, dim, 2, dtype=jnp.float32) / dim))
    ang = jnp.arange(seq, dtype=jnp.float32)[:, None] * inv[None, :]
    return jnp.cos(ang), jnp.sin(ang)


def apply_rope(x, cos, sin):
    xf = x.astype(jnp.float32)
    half = x.shape[-1] // 2
    x1, x2 = xf[..., :half], xf[..., half:]
    c = cos[None, :, None, :]
    s = sin[None, :, None, :]
    return jnp.concatenate([x1 * c - x2 * s, x2 * c + x1 * s], axis=-1).astype(x.dtype)


def window_gqa_sink(q, k, v, sink):
    B, S = q.shape[0], q.shape[1]
    nb = S // BLOCK
    qb = q.reshape(B, nb, BLOCK, KVA, GA, DA)
    pad = ((0, 0), (BLOCK, BLOCK), (0, 0), (0, 0))

    def bands(t):
        tb = jnp.pad(t, pad).reshape(B, nb + 2, BLOCK, KVA, DA)
        return jnp.concatenate([tb[:, :-2], tb[:, 1:-1], tb[:, 2:]], axis=2)

    kb, vb = bands(k), bands(v)
    s = jnp.einsum('bnqkgd,bnskd->bnkgqs', qb, kb).astype(jnp.float32) * (DA ** -0.5)
    blk = jnp.arange(nb)[:, None, None] * BLOCK
    qpos = blk + jnp.arange(BLOCK)[None, :, None]
    kpos = blk - BLOCK + jnp.arange(3 * BLOCK)[None, None, :]
    valid = (jnp.abs(qpos - kpos) <= WINDOW) & (kpos >= 0) & (kpos < S)
    s = jnp.where(valid[None, :, None, None], s, NEG)
    sink_l = sink.astype(jnp.float32).reshape(KVA, GA)[None, None, :, :, None, None]
    m = jnp.maximum(jnp.max(s, axis=-1, keepdims=True), sink_l)
    p = jnp.exp(s - m)
    denom = jnp.sum(p, axis=-1, keepdims=True) + jnp.exp(sink_l - m)
    o = jnp.einsum('bnkgqs,bnskd->bnqkgd', (p / denom).astype(v.dtype), vb)
    return o.reshape(B, S, HA * DA)


def mla(c_q, c_kv, k_rope, cq_g, w_uq, ckv_g, w_ukv, cos_r, sin_r):
    B, S = c_q.shape[0], c_q.shape[1]
    q = (rms_norm(c_q, cq_g) @ w_uq).reshape(B, S, HB, DN + DR)
    q_nope = q[..., :DN]
    q_rope = apply_rope(q[..., DN:], cos_r, sin_r)
    kv = (rms_norm(c_kv, ckv_g) @ w_ukv).reshape(B, S, HB, DN + DV)
    k_nope, v = kv[..., :DN], kv[..., DN:]
    k_r = apply_rope(k_rope[:, :, None, :], cos_r, sin_r)[:, :, 0]
    nb = S // BLOCK
    qn = q_nope.reshape(B, nb, BLOCK, HB, DN).transpose(1, 0, 2, 3, 4)
    qr = q_rope.reshape(B, nb, BLOCK, HB, DR).transpose(1, 0, 2, 3, 4)
    scale = (DN + DR) ** -0.5

    def block(args):
        qn_b, qr_b = args
        s = (jnp.einsum('bqhd,bshd->bhqs', qn_b, k_nope)
             + jnp.einsum('bqhr,bsr->bhqs', qr_b, k_r)).astype(jnp.float32) * scale
        p = jax.nn.softmax(s, axis=-1)
        return jnp.einsum('bhqs,bshd->bqhd', p.astype(v.dtype), v)

    o = lax.map(block, (qn, qr))
    return o.transpose(1, 0, 2, 3, 4).reshape(B, S, HB * DV)


def encoder_layer(x, cos_a, sin_a, cos_r, sin_r, g_mix, w_in, sink, cq_g, w_uq, ckv_g, w_ukv,
                  w_o, g_ffn, w_gate, w_up, w_down):
    B, S = x.shape[0], x.shape[1]
    h = rms_norm(x, g_mix)
    z = h @ w_in
    idx = list(np.cumsum(SPLIT_SIZES)[:-1])
    qa, ka, va, c_q, c_kv, k_rope = jnp.split(z, idx, axis=-1)
    qa = apply_rope(qa.reshape(B, S, HA, DA), cos_a, sin_a)
    ka = apply_rope(ka.reshape(B, S, KVA, DA), cos_a, sin_a)
    va = va.reshape(B, S, KVA, DA)
    o_a = window_gqa_sink(qa, ka, va, sink)
    o_b = mla(c_q, c_kv, k_rope, cq_g, w_uq, ckv_g, w_ukv, cos_r, sin_r)
    x = x + jnp.concatenate([o_a, o_b], axis=-1) @ w_o
    h = rms_norm(x, g_ffn)
    x = x + (jax.nn.silu(h @ w_gate) * (h @ w_up)) @ w_down
    return x


def trunk(x, g_mix, w_in, sink, cq_g, w_uq, ckv_g, w_ukv, w_o, g_ffn, w_gate, w_up, w_down, g_final):
    S = x.shape[1]
    cos_a, sin_a = rope_tables(S, DA)
    cos_r, sin_r = rope_tables(S, DR)
    for l in range(DEPTH):
        x = encoder_layer(x, cos_a, sin_a, cos_r, sin_r, g_mix[l], w_in[l], sink[l], cq_g[l], w_uq[l],
                          ckv_g[l], w_ukv[l], w_o[l], g_ffn[l], w_gate[l], w_up[l], w_down[l])
    return rms_norm(x, g_final)


def setup_inputs(seed: int = 0) -> dict:
    key = jax.random.key(seed)
    ks = jax.random.split(key, 16)
    f32 = jnp.float32

    def nrm(k, shape, scale):
        return jax.random.normal(k, shape, f32) * scale

    def gain(k, n):
        return 1.0 + 0.01 * jax.random.normal(k, (DEPTH, n), f32)

    return {
        "x_prompt": jax.random.normal(ks[0], (BATCH, SEQ, D_MODEL), f32),
        "x_sample": jax.random.normal(ks[1], (DEC_BATCH, DEC_SEQ, D_MODEL), f32),
        "g_mix": gain(ks[2], D_MODEL),
        "w_in": nrm(ks[3], (DEPTH, D_MODEL, D_IN), D_MODEL ** -0.5),
        "sink": nrm(ks[4], (DEPTH, HA), 0.5),
        "cq_g": gain(ks[5], Q_RANK),
        "w_uq": nrm(ks[6], (DEPTH, Q_RANK, HB * (DN + DR)), Q_RANK ** -0.5),
        "ckv_g": gain(ks[7], KV_RANK),
        "w_ukv": nrm(ks[8], (DEPTH, KV_RANK, HB * (DN + DV)), KV_RANK ** -0.5),
        "w_o": nrm(ks[9], (DEPTH, D_MIX, D_MODEL), D_MIX ** -0.5),
        "g_ffn": gain(ks[10], D_MODEL),
        "w_gate": nrm(ks[11], (DEPTH, D_MODEL, D_FF), D_MODEL ** -0.5),
        "w_up": nrm(ks[12], (DEPTH, D_MODEL, D_FF), D_MODEL ** -0.5),
        "w_down": nrm(ks[13], (DEPTH, D_FF, D_MODEL), D_FF ** -0.5),
        "g_final": 1.0 + 0.01 * jax.random.normal(ks[14], (D_MODEL,), f32),
    }


def reference(x_prompt, x_sample, g_mix, w_in, sink, cq_g, w_uq, ckv_g, w_ukv, w_o, g_ffn,
              w_gate, w_up, w_down, g_final):
    y_prompt = trunk(x_prompt, g_mix, w_in, sink, cq_g, w_uq, ckv_g, w_ukv, w_o, g_ffn,
                     w_gate, w_up, w_down, g_final)
    y_sample = trunk(x_sample, g_mix, w_in, sink, cq_g, w_uq, ckv_g, w_ukv, w_o, g_ffn,
                     w_gate, w_up, w_down, g_final)
    return (y_prompt, y_sample)
```

```cpp
#include <hip/hip_runtime.h>
#include <cstdio>
#include <cstdint>

typedef unsigned short bf16_t;
typedef short bf16x8 __attribute__((ext_vector_type(8)));
typedef float f32x4 __attribute__((ext_vector_type(4)));
typedef unsigned u32x4 __attribute__((ext_vector_type(4)));

constexpr int M = 49152, MPROMPT = 32768, DM = 1024;
constexpr int DIN = 1440, DINP = 1536;
constexpr int HA = 8, DA = 64, HB = 8, QRANK = 384, KVRANK = 256, DN = 64, DR = 32, DV = 64, WINDOW = 128;
constexpr int DFF = 2816, NGU = 2 * DFF;
constexpr float EPS = 1e-6f, LOG2E = 1.4426950408889634f;
constexpr float C2A = 0.125f * LOG2E;
constexpr float C2B = 0.10206207261596577f * LOG2E;

constexpr size_t MiB = 1u << 20;
constexpr size_t WS_CTL = 0;
constexpr size_t WS_COSA = 1 * MiB, WS_SINA = 2 * MiB, WS_COSR = 3 * MiB, WS_SINR = 3 * MiB + 512 * 1024;
constexpr size_t WS_RSTD0 = 4 * MiB, WS_RSTDQ = WS_RSTD0 + 192 * 1024, WS_RSTDKV = WS_RSTDQ + 192 * 1024, WS_RSTD1 = WS_RSTDKV + 192 * 1024;
constexpr size_t WS_WIN = 5 * MiB, WS_WUQ = 8 * MiB, WS_WUKV = 9 * MiB, WS_WO = 10 * MiB, WS_WGU = 12 * MiB, WS_WDOWN = 23 * MiB;
constexpr size_t WS_XB = 32 * MiB, WS_O = 32 * MiB;
constexpr size_t WS_QA = 128 * MiB, WS_KA = 176 * MiB, WS_VA = 188 * MiB, WS_CQ = 200 * MiB, WS_CKV = 236 * MiB;
constexpr size_t WS_QB = 260 * MiB, WS_K96 = 332 * MiB, WS_VB = 404 * MiB;
constexpr size_t WS_H = 128 * MiB, WS_ACT = 224 * MiB, WS_END = 488 * MiB;

struct Params {
    const float *x, *g_mix, *w_in, *sink, *cq_g, *w_uq, *ckv_g, *w_ukv, *w_o, *g_ffn, *w_gate, *w_up, *w_down, *g_final;
    float* out; unsigned char* ws;
};

__device__ __forceinline__ unsigned pk2(float lo, float hi) {
    typedef float f2 __attribute__((ext_vector_type(2))); typedef __bf16 b2 __attribute__((ext_vector_type(2)));
    f2 v = {lo, hi}; b2 b = __builtin_convertvector(v, b2); return __builtin_bit_cast(unsigned, b);
}
__device__ __forceinline__ float bf2f(unsigned h) { return __uint_as_float(h << 16); }
__device__ __forceinline__ void store8(bf16_t* p, const float* v) {
    u32x4 w; w.x = pk2(v[0], v[1]); w.y = pk2(v[2], v[3]); w.z = pk2(v[4], v[5]); w.w = pk2(v[6], v[7]); *(u32x4*)p = w;
}
__device__ __forceinline__ void row_info(int row, int& t, int& sbase, int& S) {
    if (row < MPROMPT) { S = 8192; t = row & 8191; sbase = row & ~8191; } else { S = 4096; t = row & 4095; sbase = row & ~4095; }
}
__device__ __forceinline__ float wave_sum(float v) {
#pragma unroll
    for (int o = 1; o < 64; o <<= 1) v += __shfl_xor(v, o);
    return v;
}
__device__ __forceinline__ float wave_max(float v) {
#pragma unroll
    for (int o = 1; o < 64; o <<= 1) v = fmaxf(v, __shfl_xor(v, o));
    return v;
}
__device__ __forceinline__ void rope4(float* v, const float* cs, const float* sn) {
    const f32x4 c = *(const f32x4*)cs, s = *(const f32x4*)sn;
#pragma unroll
    for (int i = 0; i < 4; ++i) { const float x1 = v[2 * i], x2 = v[2 * i + 1]; v[2 * i] = x1 * c[i] - x2 * s[i]; v[2 * i + 1] = x2 * c[i] + x1 * s[i]; }
}

__host__ __device__ __forceinline__ int map_win(int n) {
    if (n < 640) { const int hb = n & ~63, j = n & 63; return hb + (j >> 1) + 32 * (j & 1); }
    if (n < 1408) return n;
    if (n < 1440) { const int j = n - 1408; return 1408 + (j >> 1) + 16 * (j & 1); }
    return -1;
}
__host__ __device__ __forceinline__ int map_wuq(int n) { const int h = n / 96, j = n % 96; if (j < 64) return n; const int jj = j - 64; return h * 96 + 64 + (jj >> 1) + 16 * (jj & 1); }
__host__ __device__ __forceinline__ int map_ident(int n) { return n; }
template <int WHICH> __device__ __forceinline__ int map_col(int n) {
    if (WHICH == 0) return map_win(n); if (WHICH == 1) return map_wuq(n); return map_ident(n);
}

template <int WHICH>
__global__ __launch_bounds__(256) void prep_weight(const float* __restrict__ src, const float* __restrict__ src2, const float* __restrict__ gain, bf16_t* __restrict__ Wt, int K, int Nsrc) {
    __shared__ float tile[64][33];
    const int tid = threadIdx.x, tx = tid & 31, ty = tid >> 5;
    const int n0 = blockIdx.x * 32, k0 = blockIdx.y * 64;
    const int n = n0 + tx;
    const float* s = src; int c;
    if (WHICH == 3) { const int t = n >> 8, r = n & 255; if (r < 128) { c = 128 * t + r; } else { c = 128 * t + r - 128; s = src2; } }
    else c = map_col<WHICH>(n);
#pragma unroll
    for (int i = 0; i < 8; ++i) { const int k = k0 + ty + 8 * i; float v = 0.f; if (c >= 0) { v = s[(size_t)k * Nsrc + c]; if (gain) v *= gain[k]; } tile[ty + 8 * i][tx] = v; }
    __syncthreads();
    const int nn = tid >> 3, kc = tid & 7;
    float v[8];
#pragma unroll
    for (int j = 0; j < 8; ++j) v[j] = tile[kc * 8 + j][nn];
    store8(Wt + (size_t)(n0 + nn) * K + k0 + kc * 8, v);
}

__global__ void prep_tables(float* cosA, float* sinA, float* cosR, float* sinR) {
    const int i = blockIdx.x * blockDim.x + threadIdx.x;
    if (i < 8192 * 32) { const int pos = i >> 5, j = i & 31; const double inv = pow(10000.0, -(double)j / 32.0); const double a = (double)pos * inv; cosA[i] = (float)cos(a); sinA[i] = (float)sin(a); }
    if (i < 8192 * 16) { const int pos = i >> 4, j = i & 15; const double inv = pow(10000.0, -(double)j / 16.0); const double a = (double)pos * inv; cosR[i] = (float)cos(a); sinR[i] = (float)sin(a); }
}

__global__ __launch_bounds__(256) void prep_x(const float* __restrict__ x, bf16_t* __restrict__ xb, float* __restrict__ rstd) {
    const int row = blockIdx.x * 4 + (threadIdx.x >> 6), lane = threadIdx.x & 63;
    const f32x4* xr = (const f32x4*)(x + (size_t)row * DM) + lane;
    f32x4 v[4]; float s = 0.f;
#pragma unroll
    for (int j = 0; j < 4; ++j) { v[j] = xr[64 * j]; s += (v[j].x * v[j].x + v[j].y * v[j].y) + (v[j].z * v[j].z + v[j].w * v[j].w); }
    s = wave_sum(s);
    if (lane == 0) rstd[row] = 1.0f / sqrtf(s * (1.0f / DM) + EPS);
    unsigned long long* o8 = (unsigned long long*)(xb + (size_t)row * DM) + lane;
#pragma unroll
    for (int j = 0; j < 4; ++j) o8[64 * j] = (unsigned long long)pk2(v[j].x, v[j].y) | ((unsigned long long)pk2(v[j].z, v[j].w) << 32);
}
__global__ __launch_bounds__(256) void rowpass_rstd_bf16(const bf16_t* __restrict__ src, int ncols, float* __restrict__ rstd) {
    const int row = blockIdx.x * 4 + (threadIdx.x >> 6), lane = threadIdx.x & 63;
    const bf16_t* p = src + (size_t)row * ncols; float s = 0.f;
    for (int c = lane * 2; c < ncols; c += 128) { const unsigned w = *(const unsigned*)(p + c); const float a = bf2f(w & 0xffffu), b = bf2f(w >> 16); s += a * a + b * b; }
    s = wave_sum(s);
    if (lane == 0) rstd[row] = 1.0f / sqrtf(s / (float)ncols + EPS);
}
__global__ __launch_bounds__(256) void rowpass_h(const float* __restrict__ x1, bf16_t* __restrict__ H) {
    const int row = blockIdx.x * 4 + (threadIdx.x >> 6), lane = threadIdx.x & 63;
    const f32x4* xr = (const f32x4*)(x1 + (size_t)row * DM) + lane;
    f32x4 v[4]; float s = 0.f;
#pragma unroll
    for (int j = 0; j < 4; ++j) { v[j] = xr[64 * j]; s += (v[j].x * v[j].x + v[j].y * v[j].y) + (v[j].z * v[j].z + v[j].w * v[j].w); }
    const float r = 1.0f / sqrtf(wave_sum(s) * (1.0f / DM) + EPS);
    unsigned long long* o8 = (unsigned long long*)(H + (size_t)row * DM) + lane;
#pragma unroll
    for (int j = 0; j < 4; ++j) o8[64 * j] = (unsigned long long)pk2(v[j].x * r, v[j].y * r) | ((unsigned long long)pk2(v[j].z * r, v[j].w * r) << 32);
}
__global__ __launch_bounds__(256) void rowpass_final(float* __restrict__ out, const float* __restrict__ g) {
    const int row = blockIdx.x * 4 + (threadIdx.x >> 6), lane = threadIdx.x & 63;
    f32x4* xr = (f32x4*)(out + (size_t)row * DM) + lane; const f32x4* gr = (const f32x4*)g + lane;
    f32x4 v[4]; float s = 0.f;
#pragma unroll
    for (int j = 0; j < 4; ++j) { v[j] = xr[64 * j]; s += (v[j].x * v[j].x + v[j].y * v[j].y) + (v[j].z * v[j].z + v[j].w * v[j].w); }
    const float r = 1.0f / sqrtf(wave_sum(s) * (1.0f / DM) + EPS);
#pragma unroll
    for (int j = 0; j < 4; ++j) xr[64 * j] = v[j] * r * gr[64 * j];
}

struct EpiZ {
    const float *rstd0, *cosA, *sinA, *cosR, *sinR; bf16_t *QA, *KA, *VA, *CQ, *CKV, *K96;
    __device__ __forceinline__ void operator()(int row, int c, float* v) const {
        if (c >= DIN) return;
        const float s = rstd0[row];
#pragma unroll
        for (int i = 0; i < 8; ++i) v[i] *= s;
        int t, sb, S; row_info(row, t, sb, S);
        if (c < 640) {
            const int j0 = (c & 63) >> 1; rope4(v, cosA + t * 32 + j0, sinA + t * 32 + j0);
            if (c < 512) {
#pragma unroll
                for (int i = 0; i < 8; ++i) v[i] *= C2A;
                store8(QA + (size_t)row * 512 + c, v);
            } else store8(KA + (size_t)row * 128 + (c - 512), v);
        } else if (c < 768) store8(VA + (size_t)row * 128 + (c - 640), v);
        else if (c < 1152) store8(CQ + (size_t)row * QRANK + (c - 768), v);
        else if (c < 1408) store8(CKV + (size_t)row * KVRANK + (c - 1152), v);
        else {
            const int jc = c - 1408, j0 = jc >> 1; rope4(v, cosR + t * 16 + j0, sinR + t * 16 + j0);
#pragma unroll
            for (int h = 0; h < HB; ++h) store8(K96 + (size_t)row * 768 + h * 96 + 64 + jc, v);
        }
    }
};
struct EpiQ {
    const float *rstdq, *cosR, *sinR; bf16_t* QB;
    __device__ __forceinline__ void operator()(int row, int c, float* v) const {
        const float s = rstdq[row] * C2B;
#pragma unroll
        for (int i = 0; i < 8; ++i) v[i] *= s;
        const int j = c % 96;
        if (j >= 64) { int t, sb, S; row_info(row, t, sb, S); const int j0 = (j - 64) >> 1; rope4(v, cosR + t * 16 + j0, sinR + t * 16 + j0); }
        store8(QB + (size_t)row * 768 + c, v);
    }
};
struct EpiKV {
    const float* rstdkv; bf16_t *K96, *VB;
    __device__ __forceinline__ void operator()(int row, int c, float* v) const {
        const float s = rstdkv[row];
#pragma unroll
        for (int i = 0; i < 8; ++i) v[i] *= s;
        const int h = c >> 7, j = c & 127;
        if (j < 64) store8(K96 + (size_t)row * 768 + h * 96 + j, v); else store8(VB + (size_t)row * 512 + h * 64 + (j - 64), v);
    }
};
struct EpiRes {
    const float* base; float* out;
    __device__ __forceinline__ void operator()(int row, int c, float* v) const {
        const f32x4* b = (const f32x4*)(base + (size_t)row * DM + c); f32x4* o = (f32x4*)(out + (size_t)row * DM + c);
        const f32x4 b0 = b[0], b1 = b[1];
        o[0] = (f32x4){v[0] + b0.x, v[1] + b0.y, v[2] + b0.z, v[3] + b0.w}; o[1] = (f32x4){v[4] + b1.x, v[5] + b1.y, v[6] + b1.z, v[7] + b1.w};
    }
};
struct EpiGU {
    bf16_t* ACT;
    __device__ __forceinline__ void operator()(int row, int c, float* g, float* u) const {
        float a[8];
#pragma unroll
        for (int i = 0; i < 8; ++i) a[i] = g[i] / (1.0f + __expf(-g[i])) * u[i];
        store8(ACT + (size_t)row * DFF + 128 * (c >> 8) + (c & 127), a);
    }
};

template <class Epi, bool DUAL>
__global__ __launch_bounds__(256) void gemm_simple(const bf16_t* __restrict__ A, const bf16_t* __restrict__ Wt, int K, Epi E) {
    const int tid = threadIdx.x, wid = tid >> 6, lane = tid & 63, fr = lane & 15, fq = lane >> 4;
    const int row0 = blockIdx.y * 64 + wid * 16;
    const int cb = DUAL ? ((int)(blockIdx.x >> 2) * 256 + (int)(blockIdx.x & 3) * 32) : (int)blockIdx.x * 32;
    const bf16_t* ap = A + (size_t)(row0 + fr) * K + fq * 8;
    const bf16_t* bp = Wt + (size_t)(cb + 8 * (fr >> 2) + (fr & 3)) * K + fq * 8;
    f32x4 acc[2] = {}, acd[2] = {};
    for (int k = 0; k < K; k += 32) {
        const bf16x8 a = *(const bf16x8*)(ap + k);
        const bf16x8 b0 = *(const bf16x8*)(bp + k), b1 = *(const bf16x8*)(bp + (size_t)4 * K + k);
        acc[0] = __builtin_amdgcn_mfma_f32_16x16x32_bf16(b0, a, acc[0], 0, 0, 0);
        acc[1] = __builtin_amdgcn_mfma_f32_16x16x32_bf16(b1, a, acc[1], 0, 0, 0);
        if (DUAL) {
            const bf16x8 d0 = *(const bf16x8*)(bp + (size_t)128 * K + k), d1 = *(const bf16x8*)(bp + (size_t)132 * K + k);
            acd[0] = __builtin_amdgcn_mfma_f32_16x16x32_bf16(d0, a, acd[0], 0, 0, 0);
            acd[1] = __builtin_amdgcn_mfma_f32_16x16x32_bf16(d1, a, acd[1], 0, 0, 0);
        }
    }
    float v[8] = {acc[0][0], acc[0][1], acc[0][2], acc[0][3], acc[1][0], acc[1][1], acc[1][2], acc[1][3]};
    if constexpr (DUAL) { float u[8] = {acd[0][0], acd[0][1], acd[0][2], acd[0][3], acd[1][0], acd[1][1], acd[1][2], acd[1][3]}; E(row0 + fr, cb + 8 * fq, v, u); }
    else E(row0 + fr, cb + 8 * fq, v);
}

template <int DQK, bool WIN>
__global__ __launch_bounds__(256) void attn_naive(const bf16_t* __restrict__ Q, int ldq, const bf16_t* __restrict__ Kp, int ldk, const bf16_t* __restrict__ Vp, int ldv,
                                                  bf16_t* __restrict__ O, int ocol0, const float* __restrict__ sink) {
    constexpr int QT = 8, KT = 256;
    __shared__ float qs[QT][DQK]; __shared__ float sc[QT][KT]; __shared__ float m_run[QT], l_run[QT], al[QT];
    const int tid = threadIdx.x, h = blockIdx.y, r0 = blockIdx.x * QT;
    int t0, sbase, S; row_info(r0, t0, sbase, S);
    const int kvh = WIN ? (h >> 2) : h;
    for (int i = tid; i < QT * DQK; i += 256) { const int qi = i / DQK, d = i % DQK; qs[qi][d] = bf2f(Q[(size_t)(r0 + qi) * ldq + h * DQK + d]); }
    if (tid < QT) { m_run[tid] = WIN ? sink[h] * LOG2E : -1e30f; l_run[tid] = WIN ? 1.f : 0.f; }
    const int klo = WIN ? max(sbase, r0 - WINDOW) : sbase, khi = WIN ? min(sbase + S, r0 + QT + WINDOW) : sbase + S;
    float acc0 = 0.f, acc1 = 0.f; const int qi_pv = tid >> 5, dp = (tid & 31) * 2;
    __syncthreads();
    for (int kt = klo; kt < khi; kt += KT) {
        const int key = kt + tid;
        if (key < khi) {
            float kr[DQK];
            const bf16_t* kp = Kp + (size_t)key * ldk + kvh * DQK;
#pragma unroll
            for (int c = 0; c < DQK / 8; ++c) { const u32x4 w = *(const u32x4*)(kp + c * 8);
                kr[c * 8 + 0] = bf2f(w.x & 0xffffu); kr[c * 8 + 1] = bf2f(w.x >> 16); kr[c * 8 + 2] = bf2f(w.y & 0xffffu); kr[c * 8 + 3] = bf2f(w.y >> 16);
                kr[c * 8 + 4] = bf2f(w.z & 0xffffu); kr[c * 8 + 5] = bf2f(w.z >> 16); kr[c * 8 + 6] = bf2f(w.w & 0xffffu); kr[c * 8 + 7] = bf2f(w.w >> 16); }
#pragma unroll
            for (int qi = 0; qi < QT; ++qi) { float s = 0.f;
#pragma unroll
                for (int d = 0; d < DQK; ++d) s += qs[qi][d] * kr[d];
                if (WIN) { const int dd = (r0 + qi) - key; if (dd > WINDOW || dd < -WINDOW) s = -1e30f; }
                sc[qi][tid] = s; }
        } else {
#pragma unroll
            for (int qi = 0; qi < QT; ++qi) sc[qi][tid] = -1e30f;
        }
        __syncthreads();
        { const int w = tid >> 6, lane = tid & 63;
#pragma unroll
          for (int rr = 0; rr < 2; ++rr) { const int qi = 2 * w + rr;
            float v0 = sc[qi][lane], v1 = sc[qi][lane + 64], v2 = sc[qi][lane + 128], v3 = sc[qi][lane + 192];
            const float mx = wave_max(fmaxf(fmaxf(v0, v1), fmaxf(v2, v3)));
            const float mo = m_run[qi], mn = fmaxf(mo, mx), a = exp2f(mo - mn);
            v0 = exp2f(v0 - mn); v1 = exp2f(v1 - mn); v2 = exp2f(v2 - mn); v3 = exp2f(v3 - mn);
            const float sm = wave_sum((v0 + v1) + (v2 + v3));
            sc[qi][lane] = v0; sc[qi][lane + 64] = v1; sc[qi][lane + 128] = v2; sc[qi][lane + 192] = v3;
            if (lane == 0) { m_run[qi] = mn; l_run[qi] = l_run[qi] * a + sm; al[qi] = a; } } }
        __syncthreads();
        { const float a = al[qi_pv]; acc0 *= a; acc1 *= a; const int n = min(KT, khi - kt);
          const bf16_t* vp = Vp + (size_t)kt * ldv + kvh * 64 + dp;
          for (int k = 0; k < n; ++k) { const float p = sc[qi_pv][k]; const unsigned vv = *(const unsigned*)(vp + (size_t)k * ldv); acc0 += p * bf2f(vv & 0xffffu); acc1 += p * bf2f(vv >> 16); } }
        __syncthreads();
    }
    const float inv = 1.0f / l_run[qi_pv];
    *(unsigned*)(O + (size_t)(r0 + qi_pv) * DM + ocol0 + h * 64 + dp) = pk2(acc0 * inv, acc1 * inv);
}

extern "C" void kernel_launch(void* const* d_in, const int* in_sizes, int n_in, void* d_out, int out_size, void* d_ws, size_t ws_size, hipStream_t stream) {
    if (n_in != 15 || in_sizes[0] != MPROMPT * DM || in_sizes[1] != (M - MPROMPT) * DM || out_size != M * DM || ws_size < WS_END) {
        fprintf(stderr, "kernel_launch: unexpected shapes: n_in %d in0 %d in1 %d out %d ws %zu (need %zu)\n", n_in, n_in > 0 ? in_sizes[0] : -1, n_in > 1 ? in_sizes[1] : -1, out_size, ws_size, (size_t)WS_END);
        return;
    }
    unsigned char* ws = (unsigned char*)d_ws;
    const float* xp = (const float*)d_in[0]; const float* xs = (const float*)d_in[1];
    const float *g_mix = (const float*)d_in[2], *w_in = (const float*)d_in[3], *sink = (const float*)d_in[4], *cq_g = (const float*)d_in[5], *w_uq = (const float*)d_in[6], *ckv_g = (const float*)d_in[7],
                *w_ukv = (const float*)d_in[8], *w_o = (const float*)d_in[9], *g_ffn = (const float*)d_in[10], *w_gate = (const float*)d_in[11], *w_up = (const float*)d_in[12], *w_down = (const float*)d_in[13], *g_final = (const float*)d_in[14];
    float* out = (float*)d_out;
    float *cosA = (float*)(ws + WS_COSA), *sinA = (float*)(ws + WS_SINA), *cosR = (float*)(ws + WS_COSR), *sinR = (float*)(ws + WS_SINR);
    float *rstd0 = (float*)(ws + WS_RSTD0), *rstdq = (float*)(ws + WS_RSTDQ), *rstdkv = (float*)(ws + WS_RSTDKV);
    bf16_t *Wt_in = (bf16_t*)(ws + WS_WIN), *Wt_uq = (bf16_t*)(ws + WS_WUQ), *Wt_ukv = (bf16_t*)(ws + WS_WUKV), *Wt_o = (bf16_t*)(ws + WS_WO), *Wt_gu = (bf16_t*)(ws + WS_WGU), *Wt_down = (bf16_t*)(ws + WS_WDOWN);
    bf16_t *XB = (bf16_t*)(ws + WS_XB), *OB = (bf16_t*)(ws + WS_O), *QA = (bf16_t*)(ws + WS_QA), *KA = (bf16_t*)(ws + WS_KA), *VA = (bf16_t*)(ws + WS_VA), *CQ = (bf16_t*)(ws + WS_CQ), *CKV = (bf16_t*)(ws + WS_CKV);
    bf16_t *QB = (bf16_t*)(ws + WS_QB), *K96 = (bf16_t*)(ws + WS_K96), *VB = (bf16_t*)(ws + WS_VB), *H = (bf16_t*)(ws + WS_H), *ACT = (bf16_t*)(ws + WS_ACT);

    prep_weight<0><<<dim3(DINP / 32, DM / 64), 256, 0, stream>>>(w_in, nullptr, g_mix, Wt_in, DM, DIN);
    prep_weight<1><<<dim3(768 / 32, QRANK / 64), 256, 0, stream>>>(w_uq, nullptr, cq_g, Wt_uq, QRANK, 768);
    prep_weight<2><<<dim3(1024 / 32, KVRANK / 64), 256, 0, stream>>>(w_ukv, nullptr, ckv_g, Wt_ukv, KVRANK, 1024);
    prep_weight<2><<<dim3(1024 / 32, DM / 64), 256, 0, stream>>>(w_o, nullptr, nullptr, Wt_o, DM, DM);
    prep_weight<3><<<dim3(NGU / 32, DM / 64), 256, 0, stream>>>(w_gate, w_up, g_ffn, Wt_gu, DM, DFF);
    prep_weight<2><<<dim3(DM / 32, DFF / 64), 256, 0, stream>>>(w_down, nullptr, nullptr, Wt_down, DFF, DM);
    prep_tables<<<8192 * 32 / 256, 256, 0, stream>>>(cosA, sinA, cosR, sinR);
    prep_x<<<MPROMPT / 4, 256, 0, stream>>>(xp, XB, rstd0);
    prep_x<<<(M - MPROMPT) / 4, 256, 0, stream>>>(xs, XB + (size_t)MPROMPT * DM, rstd0 + MPROMPT);
    { EpiZ E{rstd0, cosA, sinA, cosR, sinR, QA, KA, VA, CQ, CKV, K96};
      gemm_simple<EpiZ, false><<<dim3(DINP / 32, M / 64), 256, 0, stream>>>(XB, Wt_in, DM, E); }
    rowpass_rstd_bf16<<<M / 4, 256, 0, stream>>>(CQ, QRANK, rstdq);
    rowpass_rstd_bf16<<<M / 4, 256, 0, stream>>>(CKV, KVRANK, rstdkv);
    { EpiQ E{rstdq, cosR, sinR, QB}; gemm_simple<EpiQ, false><<<dim3(768 / 32, M / 64), 256, 0, stream>>>(CQ, Wt_uq, QRANK, E); }
    { EpiKV E{rstdkv, K96, VB}; gemm_simple<EpiKV, false><<<dim3(1024 / 32, M / 64), 256, 0, stream>>>(CKV, Wt_ukv, KVRANK, E); }
    attn_naive<64, true><<<dim3(M / 8, HA), 256, 0, stream>>>(QA, 512, KA, 128, VA, 128, OB, 0, sink);
    attn_naive<96, false><<<dim3(M / 8, HB), 256, 0, stream>>>(QB, 768, K96, 768, VB, 512, OB, 512, nullptr);
    { EpiRes E{xp, out}; gemm_simple<EpiRes, false><<<dim3(DM / 32, MPROMPT / 64), 256, 0, stream>>>(OB, Wt_o, DM, E); }
    { EpiRes E{xs, out + (size_t)MPROMPT * DM}; gemm_simple<EpiRes, false><<<dim3(DM / 32, (M - MPROMPT) / 64), 256, 0, stream>>>(OB + (size_t)MPROMPT * DM, Wt_o, DM, E); }
    rowpass_h<<<M / 4, 256, 0, stream>>>(out, H);
    { EpiGU E{ACT}; gemm_simple<EpiGU, true><<<dim3((NGU / 256) * 4, M / 64), 256, 0, stream>>>(H, Wt_gu, DM, E); }
    { EpiRes E{out, out}; gemm_simple<EpiRes, false><<<dim3(DM / 32, M / 64), 256, 0, stream>>>(ACT, Wt_down, DFF, E); }
    rowpass_final<<<M / 4, 256, 0, stream>>>(out, g_final);
}
```

```cpp
#include <hip/hip_runtime.h>
#include <hip/hip_cooperative_groups.h>
#include <cstdio>
#include <cstdint>
namespace cg = cooperative_groups;

typedef unsigned short bf16_t;
typedef short bf16x8 __attribute__((ext_vector_type(8)));
typedef float f32x4 __attribute__((ext_vector_type(4)));
typedef unsigned u32x4 __attribute__((ext_vector_type(4)));
#define LAS __attribute__((address_space(3)))

constexpr int M = 49152, MPROMPT = 32768, DM = 1024;
constexpr int DIN = 1440, DINP = 1536;
constexpr int HA = 8, HB = 8, QRANK = 384, KVRANK = 256, WINDOW = 128;
constexpr int DFF = 2816, NGU = 2 * DFF;
constexpr float EPS = 1e-6f, LOG2E = 1.4426950408889634f;
constexpr float C2A = 0.125f * LOG2E;
constexpr float C2B = 0.10206207261596577f * LOG2E;

constexpr size_t MiB = 1u << 20;
constexpr size_t WS_COSA = 1 * MiB, WS_SINA = 2 * MiB, WS_COSR = 3 * MiB, WS_SINR = 3 * MiB + 512 * 1024;
constexpr size_t WS_RSTD0 = 4 * MiB;
constexpr size_t WS_WIN = 5 * MiB, WS_WUQ = 8 * MiB, WS_WUKV = 9 * MiB, WS_WO = 10 * MiB, WS_WGU = 12 * MiB, WS_WDOWN = 23 * MiB;
constexpr size_t WS_SS = 488 * MiB;
constexpr size_t WS_XB = 32 * MiB, WS_O = 32 * MiB;
constexpr size_t WS_QA = 128 * MiB, WS_KA = 176 * MiB, WS_VA = 188 * MiB, WS_CQ = 200 * MiB, WS_CKV = 236 * MiB;
constexpr size_t WS_QB = 260 * MiB, WS_K96 = 332 * MiB, WS_VB = 404 * MiB;
constexpr size_t WS_H = 128 * MiB, WS_ACT = 224 * MiB, WS_END = 493 * MiB;

__device__ __forceinline__ unsigned pk2(float lo, float hi) {
    typedef float f2 __attribute__((ext_vector_type(2))); typedef __bf16 b2 __attribute__((ext_vector_type(2)));
    f2 v = {lo, hi}; b2 b = __builtin_convertvector(v, b2); return __builtin_bit_cast(unsigned, b);
}
__device__ __forceinline__ float bf2f(unsigned h) { return __uint_as_float(h << 16); }
__device__ __forceinline__ void store8(bf16_t* p, const float* v) {
    u32x4 w; w.x = pk2(v[0], v[1]); w.y = pk2(v[2], v[3]); w.z = pk2(v[4], v[5]); w.w = pk2(v[6], v[7]); *(u32x4*)p = w;
}
__device__ __forceinline__ void row_info(int row, int& t, int& sbase, int& S) {
    if (row < MPROMPT) { S = 8192; t = row & 8191; sbase = row & ~8191; } else { S = 4096; t = row & 4095; sbase = row & ~4095; }
}
__device__ __forceinline__ float wave_sum(float v) {
#pragma unroll
    for (int o = 1; o < 64; o <<= 1) v += __shfl_xor(v, o);
    return v;
}
__device__ __forceinline__ float wave_max(float v) {
#pragma unroll
    for (int o = 1; o < 64; o <<= 1) v = fmaxf(v, __shfl_xor(v, o));
    return v;
}
__device__ __forceinline__ void rope4(float* v, const float* cs, const float* sn) {
    const f32x4 c = *(const f32x4*)cs, s = *(const f32x4*)sn;
#pragma unroll
    for (int i = 0; i < 4; ++i) { const float x1 = v[2 * i], x2 = v[2 * i + 1]; v[2 * i] = x1 * c[i] - x2 * s[i]; v[2 * i + 1] = x2 * c[i] + x1 * s[i]; }
}

__device__ __forceinline__ int map_win(int n) {
    if (n < 640) { const int hb = n & ~63, j = n & 63; return hb + (j >> 1) + 32 * (j & 1); }
    if (n < 1408) return n;
    if (n < 1440) { const int j = n - 1408; return 1408 + (j >> 1) + 16 * (j & 1); }
    return -1;
}
__device__ __forceinline__ int map_wuq(int n) { const int h = n / 96, j = n % 96; if (j < 64) return n; const int jj = j - 64; return h * 96 + 64 + (jj >> 1) + 16 * (jj & 1); }

struct EpiZ {
    const float *rstd0, *cosA, *sinA, *cosR, *sinR; bf16_t *QA, *KA, *VA, *CQ, *CKV, *K96; float* SS;
    __device__ __forceinline__ float rowscale(int row) const { return rstd0[row]; }
    __device__ __forceinline__ void operator()(int row, int c, float* v, float s) const {
        if (c >= DIN) return;
#pragma unroll
        for (int i = 0; i < 8; ++i) v[i] *= s;
        int t, sb, S; row_info(row, t, sb, S);
        if (c < 640) {
            const int j0 = (c & 63) >> 1; rope4(v, cosA + t * 32 + j0, sinA + t * 32 + j0);
            if (c < 512) {
#pragma unroll
                for (int i = 0; i < 8; ++i) v[i] *= C2A;
                store8(QA + (size_t)row * 512 + c, v);
            } else store8(KA + (size_t)row * 128 + (c - 512), v);
        } else if (c < 768) store8(VA + (size_t)row * 128 + (c - 640), v);
        else if (c < 1408) {
            float ss = 0.f;
#pragma unroll
            for (int i = 0; i < 8; ++i) ss += v[i] * v[i];
            ss += __shfl_xor(ss, 16); ss += __shfl_xor(ss, 32);
            if ((c & 31) == 0) SS[(size_t)row * 24 + ((c - 768) >> 5)] = ss;
            if (c < 1152) store8(CQ + (size_t)row * QRANK + (c - 768), v); else store8(CKV + (size_t)row * KVRANK + (c - 1152), v);
        } else {
            const int jc = c - 1408, j0 = jc >> 1; rope4(v, cosR + t * 16 + j0, sinR + t * 16 + j0);
#pragma unroll
            for (int h = 0; h < HB; ++h) store8(K96 + (size_t)row * 768 + h * 96 + 64 + jc, v);
        }
    }
};
struct EpiQ {
    const float *SS, *cosR, *sinR; bf16_t* QB;
    __device__ __forceinline__ float rowscale(int row) const {
        const f32x4* p = (const f32x4*)(SS + (size_t)row * 24); const f32x4 a = p[0], b = p[1], c = p[2];
        const float s = ((a.x + a.y) + (a.z + a.w)) + ((b.x + b.y) + (b.z + b.w)) + ((c.x + c.y) + (c.z + c.w));
        return C2B / sqrtf(s * (1.0f / QRANK) + EPS);
    }
    __device__ __forceinline__ void operator()(int row, int c, float* v, float s) const {
#pragma unroll
        for (int i = 0; i < 8; ++i) v[i] *= s;
        const int j = c % 96;
        if (j >= 64) { int t, sb, S; row_info(row, t, sb, S); const int j0 = (j - 64) >> 1; rope4(v, cosR + t * 16 + j0, sinR + t * 16 + j0); }
        store8(QB + (size_t)row * 768 + c, v);
    }
};
struct EpiKV {
    const float* SS; bf16_t *K96, *VB;
    __device__ __forceinline__ float rowscale(int row) const {
        const f32x4* p = (const f32x4*)(SS + (size_t)row * 24 + 12); const f32x4 a = p[0], b = p[1];
        const float s = ((a.x + a.y) + (a.z + a.w)) + ((b.x + b.y) + (b.z + b.w));
        return 1.0f / sqrtf(s * (1.0f / KVRANK) + EPS);
    }
    __device__ __forceinline__ void operator()(int row, int c, float* v, float s) const {
#pragma unroll
        for (int i = 0; i < 8; ++i) v[i] *= s;
        const int h = c >> 7, j = c & 127;
        if (j < 64) store8(K96 + (size_t)row * 768 + h * 96 + j, v); else store8(VB + (size_t)row * 512 + h * 64 + (j - 64), v);
    }
};
struct EpiRes {
    const float *base_p, *base_s; float* out;
    __device__ __forceinline__ float rowscale(int) const { return 1.f; }
    __device__ __forceinline__ void operator()(int row, int c, float* v, float) const {
        const float* bb = row < MPROMPT ? base_p + (size_t)row * DM : base_s + (size_t)(row - MPROMPT) * DM;
        const f32x4* b = (const f32x4*)(bb + c); f32x4* o = (f32x4*)(out + (size_t)row * DM + c);
        const f32x4 b0 = b[0], b1 = b[1];
        o[0] = (f32x4){v[0] + b0.x, v[1] + b0.y, v[2] + b0.z, v[3] + b0.w}; o[1] = (f32x4){v[4] + b1.x, v[5] + b1.y, v[6] + b1.z, v[7] + b1.w};
    }
};
struct EpiGU {
    bf16_t* ACT;
    __device__ __forceinline__ float rowscale(int) const { return 1.f; }
    __device__ __forceinline__ void operator()(int row, int c, const float* g, const float* u, float) const {
        float a[8];
#pragma unroll
        for (int i = 0; i < 8; ++i) a[i] = g[i] * __builtin_amdgcn_rcpf(1.0f + __builtin_amdgcn_exp2f(-LOG2E * g[i])) * u[i];
        store8(ACT + (size_t)row * DFF + 128 * (c >> 8) + (c & 127), a);
    }
};

namespace pg8 {
#define PG8_LAS __attribute__((address_space(3)))
typedef unsigned short bf16_t;
typedef short bf16x8 __attribute__((ext_vector_type(8)));
typedef float f32x4 __attribute__((ext_vector_type(4)));
typedef unsigned u32x4 __attribute__((ext_vector_type(4)));
constexpr int BM = 256, BK = 64, HALF = 128, HTB = HALF * BK * 2  , STAGE_BYTES = 8 * HTB, NXCD = 8, WGM = 8;

__host__ __device__ __forceinline__ int lds_byte(int r, int c) { const int st = (r >> 4) * 2 + (c >> 5), rr = r & 15, cc = c & 31, ob = rr * 64 + cc * 2; return st * 1024 + (ob ^ (((ob >> 9) & 1) << 5)); }
__host__ __device__ __forceinline__ void stage_rc(int b, int& R, int& C) { const int st = b / 1024, sb = b % 1024, swz = sb ^ (((sb >> 9) & 1) << 5); R = (st >> 1) * 16 + swz / 64; C = (st & 1) * 32 + (swz % 64) / 2; }
__host__ __device__ __forceinline__ int perm32(int rho) { const int n = rho >> 4, i = rho & 15; return 8 * (i >> 2) + 4 * n + (i & 3); }

struct Unit { int pm, pn; };
struct Gemm { const bf16_t* A; const bf16_t* Bt; int M, N, K; };

struct StaticOrder {
    int nM, nN, nwg, G, c;
    __host__ __device__ void init(int M, int N, int G_, int c_) { nM = M / BM; nN = N / BM; nwg = nM * nN; G = G_; c = c_; }
    __host__ __device__ bool next(int i, Unit& u) const {
        const long L = (long)i * G + c; if (L >= nwg) return false;
        int wgid = (int)L; { const int q = nwg / NXCD, r = nwg % NXCD, xcd = wgid % NXCD, off = wgid / NXCD; wgid = (xcd < r ? xcd * (q + 1) : r * (q + 1) + (xcd - r) * q) + off; }
        const int nig = WGM * nN, gid = wgid / nig, fm = gid * WGM, gsz = (nM - fm) < WGM ? (nM - fm) : WGM;
        u.pm = fm + ((wgid % nig) % gsz); u.pn = (wgid % nig) / gsz; return true;
    }
    __device__ __forceinline__ void a_ready(const Unit&) const {}
    __device__ __forceinline__ void done(const Unit&) const {}
};

template <class Epi, class Sched, bool ALIGN_EPI = false, bool SP2 = false>
__device__ __forceinline__ void gemm_phase(PG8_LAS unsigned char* lds, const Gemm g, const Sched& S, const Epi& E) {
    const int tid = threadIdx.x, wid = __builtin_amdgcn_readfirstlane(tid >> 6), lane = tid & 63, wr = wid >> 2, wc = wid & 3, fr = lane & 15, fq = lane >> 4;
    const int K = g.K, nt = K / BK;
    unsigned voffA[2], voffB[2];
#pragma unroll
    for (int i = 0; i < 2; ++i) { int R, C; stage_rc(tid * 16 + i * 8192, R, C); const int Rb = Epi::PERM ? ((R & ~31) + perm32(R & 31)) : R;
        voffA[i] = (unsigned)(R * K + C) * 2u; voffB[i] = (unsigned)(Rb * K + C) * 2u; }
    const size_t kstep = (size_t)(BK * 2);
    const size_t hstep = (size_t)HALF * K * 2;
    const size_t tstep = 2 * hstep;
    const unsigned ldsw = (unsigned)wid * 1024u;
    const int aoff = lds_byte(wr * 64 + fr, fq * 8), boff = lds_byte(wc * 32 + fr, fq * 8);
#define PG8_SA(b, h) (((b) * 2 + (h)) * HTB)
#define PG8_SB(b, h) ((4 + (b) * 2 + (h)) * HTB)
#define PG8_STAGE(bufoff, gbase, voff) do { _Pragma("unroll") for (int _i = 0; _i < 2; ++_i) \
        __builtin_amdgcn_global_load_lds((const unsigned*)((const char*)(gbase) + (voff)[_i]), (PG8_LAS unsigned*)(lds + (bufoff) + ldsw + _i * 8192), 16, 0, 0); } while (0)
#define PG8_LDA(dst, b, h) do { _Pragma("unroll") for (int m = 0; m < 4; ++m) _Pragma("unroll") for (int k = 0; k < 2; ++k) dst[m][k] = *(const PG8_LAS bf16x8*)(lds + PG8_SA(b, h) + aoff + m * 2048 + k * 1024); } while (0)
#define PG8_LDB(dst, b, h) do { _Pragma("unroll") for (int n = 0; n < 2; ++n) _Pragma("unroll") for (int k = 0; k < 2; ++k) dst[n][k] = *(const PG8_LAS bf16x8*)(lds + PG8_SB(b, h) + boff + n * 2048 + k * 1024); } while (0)
#define PG8_MMA(ai, bj, At, Bt) do { __builtin_amdgcn_s_setprio(1); _Pragma("unroll") for (int m = 0; m < 4; ++m) _Pragma("unroll") for (int n = 0; n < 2; ++n) _Pragma("unroll") for (int k = 0; k < 2; ++k) \
        acc[ai][bj][m][n] = __builtin_amdgcn_mfma_f32_16x16x32_bf16(Bt[n][k], At[m][k], acc[ai][bj][m][n], 0, 0, 0); __builtin_amdgcn_s_setprio(0); } while (0)
#define PG8_WAIT_V(n) asm volatile("s_waitcnt vmcnt(" #n ")" ::: "memory")
#define PG8_WAIT_L(n) asm volatile("s_waitcnt lgkmcnt(" #n ")" ::: "memory")
#define PG8_BAR __builtin_amdgcn_s_barrier()
#define PG8_SCHED __builtin_amdgcn_sched_barrier(0)
    Unit cur, nxt; int ui = 0;
    if (!S.next(0, cur)) return;
    f32x4 acc[2][2][4][2];
#pragma unroll
    for (int a = 0; a < 2; ++a)
#pragma unroll
        for (int b = 0; b < 2; ++b)
#pragma unroll
            for (int m = 0; m < 4; ++m)
#pragma unroll
                for (int n = 0; n < 2; ++n) acc[a][b][m][n] = (f32x4){0.f, 0.f, 0.f, 0.f};
    bf16x8 At[4][2], B0[2][2], B1[2][2];
    const char* cA = (const char*)g.A + (size_t)cur.pm * tstep; const char* cB = (const char*)g.Bt + (size_t)cur.pn * tstep;
    S.a_ready(cur);
    if constexpr (SP2) {
        PG8_STAGE(PG8_SB(0, 0), cB, voffB); PG8_STAGE(PG8_SB(0, 1), cB + hstep, voffB); PG8_STAGE(PG8_SA(0, 0), cA, voffA); PG8_STAGE(PG8_SA(0, 1), cA + hstep, voffA);
        if (wr == 1) PG8_BAR;
        PG8_WAIT_V(2); PG8_BAR;
        PG8_STAGE(PG8_SB(1, 0), cB + kstep, voffB); PG8_STAGE(PG8_SA(1, 0), cA + kstep, voffA); PG8_STAGE(PG8_SB(1, 1), cB + hstep + kstep, voffB);
        PG8_WAIT_V(6); PG8_BAR;
    } else {
        PG8_STAGE(PG8_SB(0, 0), cB, voffB); PG8_STAGE(PG8_SA(0, 0), cA, voffA); PG8_STAGE(PG8_SB(0, 1), cB + hstep, voffB); PG8_STAGE(PG8_SA(0, 1), cA + hstep, voffA);
        if (wr == 1) PG8_BAR;
        PG8_WAIT_V(4); PG8_BAR;
        PG8_STAGE(PG8_SB(1, 0), cB + kstep, voffB); PG8_STAGE(PG8_SA(1, 0), cA + kstep, voffA); PG8_STAGE(PG8_SB(1, 1), cB + hstep + kstep, voffB);
        PG8_WAIT_V(6); PG8_BAR;
    }
    for (;;) {
        const bool has_next = S.next(ui + 1, nxt);
        const char* nA = has_next ? (const char*)g.A + (size_t)nxt.pm * tstep : cA; const char* nB = has_next ? (const char*)g.Bt + (size_t)nxt.pn * tstep : cB;
        for (int t = 0; t < nt; t += 2) {
            const bool last = (t == nt - 2);
            const char* a1 = cA + (size_t)(t + 1) * kstep;
            const char* a2 = last ? nA : cA + (size_t)(t + 2) * kstep; const char* b2 = last ? nB : cB + (size_t)(t + 2) * kstep;
            const char* a3 = a2 + kstep; const char* b3 = b2 + kstep;
            if (last && has_next) S.a_ready(nxt);
            if constexpr (SP2) {
            PG8_LDB(B0, 0, 0); PG8_LDB(B1, 0, 1); PG8_SCHED; PG8_LDA(At, 0, 0); PG8_STAGE(PG8_SA(1, 1), a1 + hstep, voffA);
            PG8_WAIT_V(8); PG8_WAIT_L(0); PG8_BAR; PG8_MMA(0, 0, At, B0); PG8_MMA(0, 1, At, B1); PG8_BAR; PG8_SCHED;
            PG8_LDA(At, 0, 1); PG8_STAGE(PG8_SB(0, 0), b2, voffB); PG8_STAGE(PG8_SB(0, 1), b2 + hstep, voffB); PG8_STAGE(PG8_SA(0, 0), a2, voffA);
            PG8_WAIT_V(8); PG8_WAIT_L(0); PG8_BAR; PG8_MMA(1, 0, At, B0); PG8_MMA(1, 1, At, B1); PG8_BAR; PG8_SCHED;
            PG8_LDB(B0, 1, 0); PG8_LDB(B1, 1, 1); PG8_SCHED; PG8_LDA(At, 1, 0); PG8_STAGE(PG8_SA(0, 1), a2 + hstep, voffA);
            PG8_WAIT_V(8); PG8_WAIT_L(0); PG8_BAR; PG8_MMA(0, 0, At, B0); PG8_MMA(0, 1, At, B1); PG8_BAR; PG8_SCHED;
            PG8_LDA(At, 1, 1); PG8_STAGE(PG8_SB(1, 0), b3, voffB); PG8_STAGE(PG8_SB(1, 1), b3 + hstep, voffB); PG8_STAGE(PG8_SA(1, 0), a3, voffA);
            PG8_WAIT_V(8); PG8_WAIT_L(0); PG8_BAR; PG8_MMA(1, 0, At, B0); PG8_MMA(1, 1, At, B1); PG8_BAR; PG8_SCHED;
            } else {
            PG8_LDB(B0, 0, 0); PG8_SCHED; PG8_LDA(At, 0, 0); PG8_STAGE(PG8_SA(1, 1), a1 + hstep, voffA);
            PG8_WAIT_L(8); PG8_BAR; PG8_WAIT_L(0); PG8_MMA(0, 0, At, B0); PG8_BAR; PG8_SCHED;
            PG8_LDB(B1, 0, 1); PG8_STAGE(PG8_SB(0, 0), b2, voffB);
            PG8_BAR; PG8_WAIT_L(0); PG8_MMA(0, 1, At, B1); PG8_BAR;
            PG8_LDA(At, 0, 1); PG8_STAGE(PG8_SA(0, 0), a2, voffA);
            PG8_BAR; PG8_WAIT_L(0); PG8_MMA(1, 0, At, B0); PG8_BAR; PG8_SCHED;
            PG8_STAGE(PG8_SB(0, 1), b2 + hstep, voffB);
            PG8_WAIT_V(6); PG8_BAR; PG8_MMA(1, 1, At, B1); PG8_BAR;
            PG8_LDB(B0, 1, 0); PG8_SCHED; PG8_LDA(At, 1, 0); PG8_STAGE(PG8_SA(0, 1), a2 + hstep, voffA);
            PG8_WAIT_L(8); PG8_BAR; PG8_WAIT_L(0); PG8_MMA(0, 0, At, B0); PG8_BAR; PG8_SCHED;
            PG8_LDB(B1, 1, 1); PG8_STAGE(PG8_SB(1, 0), b3, voffB);
            PG8_BAR; PG8_WAIT_L(0); PG8_MMA(0, 1, At, B1); PG8_BAR;
            PG8_LDA(At, 1, 1); PG8_STAGE(PG8_SA(1, 0), a3, voffA);
            PG8_BAR; PG8_WAIT_L(0); PG8_MMA(1, 0, At, B0); PG8_BAR; PG8_SCHED;
            PG8_STAGE(PG8_SB(1, 1), b3 + hstep, voffB);
            PG8_WAIT_V(6); PG8_BAR; PG8_MMA(1, 1, At, B1); PG8_BAR;
            }
        }
        if constexpr (ALIGN_EPI) { if (wr == 0) PG8_BAR; }
        if constexpr (!Epi::AFTER_DRAIN) { E(acc, cur, wr, wc, fr, fq); S.done(cur); }
        if (!has_next) break;
#pragma unroll
        for (int a = 0; a < 2; ++a)
#pragma unroll
            for (int b = 0; b < 2; ++b)
#pragma unroll
                for (int m = 0; m < 4; ++m)
#pragma unroll
                    for (int n = 0; n < 2; ++n) acc[a][b][m][n] = (f32x4){0.f, 0.f, 0.f, 0.f};
        cur = nxt; cA = nA; cB = nB; ++ui;
        if constexpr (ALIGN_EPI) { if (wr == 1) PG8_BAR; }
    }
    PG8_WAIT_V(0);
    if constexpr (!ALIGN_EPI) { if (wr == 0) PG8_BAR; }
    PG8_BAR;
    if constexpr (Epi::AFTER_DRAIN) { E.fused(acc, cur, wr, wc, fr, fq, lds, wid, lane); S.done(cur); }
#undef PG8_SA
#undef PG8_SB
#undef PG8_STAGE
#undef PG8_LDA
#undef PG8_LDB
#undef PG8_MMA
#undef PG8_WAIT_V
#undef PG8_WAIT_L
#undef PG8_BAR
#undef PG8_SCHED
}
}

template <class F> struct EpiRow8 {
    static constexpr bool PERM = true, AFTER_DRAIN = false; F f;
    __device__ __forceinline__ void operator()(const pg8::f32x4 (&acc)[2][2][4][2], const pg8::Unit& u, int wr, int wc, int fr, int fq) const {
        const int row0 = u.pm * 256 + wr * 64 + fr, col0 = u.pn * 256 + wc * 32 + 8 * fq;
#pragma unroll
        for (int ai = 0; ai < 2; ++ai)
#pragma unroll
            for (int m = 0; m < 4; ++m) { const int row = row0 + ai * 128 + m * 16; const float rs = f.rowscale(row);
#pragma unroll
                for (int bj = 0; bj < 2; ++bj) { const pg8::f32x4 a = acc[ai][bj][m][0], b = acc[ai][bj][m][1];
                    float v[8] = {a[0], a[1], a[2], a[3], b[0], b[1], b[2], b[3]}; f(row, col0 + bj * 128, v, rs); }
                if (m & 1) asm volatile("" ::: "memory"); }
    }
};
template <class F> struct EpiDual8 {
    static constexpr bool PERM = true, AFTER_DRAIN = false; F f;
    __device__ __forceinline__ void operator()(const pg8::f32x4 (&acc)[2][2][4][2], const pg8::Unit& u, int wr, int wc, int fr, int fq) const {
        const int row0 = u.pm * 256 + wr * 64 + fr, col0 = u.pn * 256 + wc * 32 + 8 * fq;
#pragma unroll
        for (int ai = 0; ai < 2; ++ai)
#pragma unroll
            for (int m = 0; m < 4; ++m) { const int row = row0 + ai * 128 + m * 16; const float rs = f.rowscale(row);
                const pg8::f32x4 a = acc[ai][0][m][0], b = acc[ai][0][m][1], c = acc[ai][1][m][0], d = acc[ai][1][m][1];
                const float g[8] = {a[0], a[1], a[2], a[3], b[0], b[1], b[2], b[3]}, uu[8] = {c[0], c[1], c[2], c[3], d[0], d[1], d[2], d[3]};
                f(row, col0, g, uu, rs); }
    }
};

constexpr int RING_BYTES = 131072, LDS_BYTES = 147456;
constexpr int NWAVES = 8, NTHREADS = 512;
#define LDS_WAIT() asm volatile("s_waitcnt lgkmcnt(0)" ::: "memory")

template <int DQK, bool WIN>
__device__ __forceinline__ void attn_naive_item(LAS unsigned char* lds, int r0, int h, const bf16_t* __restrict__ Q, int ldq, const bf16_t* __restrict__ Kp, int ldk,
                                                const bf16_t* __restrict__ Vp, int ldv, bf16_t* __restrict__ O, int ocol0, const float* __restrict__ sink) {
    constexpr int QT = 16, KT = 512;
    LAS float* qs = (LAS float*)lds;
    LAS float* sc = (LAS float*)(lds + QT * 96 * 4);
    LAS float* m_run = sc + QT * KT; LAS float* l_run = m_run + QT; LAS float* al = l_run + QT;
    const int tid = threadIdx.x;
    int t0, sbase, S; row_info(r0, t0, sbase, S);
    const int kvh = WIN ? (h >> 2) : h;
    for (int i = tid; i < QT * DQK; i += NTHREADS) { const int qi = i / DQK, d = i % DQK; qs[qi * DQK + d] = bf2f(Q[(size_t)(r0 + qi) * ldq + h * DQK + d]); }
    if (tid < QT) { m_run[tid] = WIN ? sink[h] * LOG2E : -1e30f; l_run[tid] = WIN ? 1.f : 0.f; }
    const int klo = WIN ? max(sbase, r0 - WINDOW) : sbase, khi = WIN ? min(sbase + S, r0 + QT + WINDOW) : sbase + S;
    float acc0 = 0.f, acc1 = 0.f; const int qi_pv = tid >> 5, dp = (tid & 31) * 2;
    __syncthreads();
    for (int kt = klo; kt < khi; kt += KT) {
        const int key = kt + tid;
        if (key < khi) {
            float kr[DQK];
            const bf16_t* kp = Kp + (size_t)key * ldk + kvh * DQK;
#pragma unroll
            for (int c = 0; c < DQK / 8; ++c) { const u32x4 w = *(const u32x4*)(kp + c * 8);
                kr[c * 8 + 0] = bf2f(w.x & 0xffffu); kr[c * 8 + 1] = bf2f(w.x >> 16); kr[c * 8 + 2] = bf2f(w.y & 0xffffu); kr[c * 8 + 3] = bf2f(w.y >> 16);
                kr[c * 8 + 4] = bf2f(w.z & 0xffffu); kr[c * 8 + 5] = bf2f(w.z >> 16); kr[c * 8 + 6] = bf2f(w.w & 0xffffu); kr[c * 8 + 7] = bf2f(w.w >> 16); }
#pragma unroll 1
            for (int qi = 0; qi < QT; ++qi) { float s = 0.f;
#pragma unroll
                for (int d = 0; d < DQK; ++d) s += qs[qi * DQK + d] * kr[d];
                if (WIN) { const int dd = (r0 + qi) - key; if (dd > WINDOW || dd < -WINDOW) s = -1e30f; }
                sc[qi * KT + tid] = s; }
        } else {
#pragma unroll 1
            for (int qi = 0; qi < QT; ++qi) sc[qi * KT + tid] = -1e30f;
        }
        __syncthreads();
        { const int w = tid >> 6, lane = tid & 63;
#pragma unroll 1
          for (int rr = 0; rr < 2; ++rr) { const int qi = 2 * w + rr; float v[8]; float mx = -1e30f;
#pragma unroll
            for (int j = 0; j < 8; ++j) { v[j] = sc[qi * KT + lane + 64 * j]; mx = fmaxf(mx, v[j]); }
            mx = wave_max(mx);
            const float mo = m_run[qi], mn = fmaxf(mo, mx), a = exp2f(mo - mn); float sm = 0.f;
#pragma unroll
            for (int j = 0; j < 8; ++j) { v[j] = exp2f(v[j] - mn); sm += v[j]; sc[qi * KT + lane + 64 * j] = v[j]; }
            sm = wave_sum(sm);
            if (lane == 0) { m_run[qi] = mn; l_run[qi] = l_run[qi] * a + sm; al[qi] = a; } } }
        __syncthreads();
        { const float a = al[qi_pv]; acc0 *= a; acc1 *= a; const int n = min(KT, khi - kt);
          const bf16_t* vp = Vp + (size_t)kt * ldv + kvh * 64 + dp;
          for (int k = 0; k < n; ++k) { const float p = sc[qi_pv * KT + k]; const unsigned vv = *(const unsigned*)(vp + (size_t)k * ldv); acc0 += p * bf2f(vv & 0xffffu); acc1 += p * bf2f(vv >> 16); } }
        __syncthreads();
    }
    const float inv = 1.0f / l_run[qi_pv];
    *(unsigned*)(O + (size_t)(r0 + qi_pv) * DM + ocol0 + h * 64 + dp) = pk2(acc0 * inv, acc1 * inv);
    __syncthreads();
}

template <int WHICH>
__device__ __forceinline__ void p0_transpose_item(const float* __restrict__ W, const float* __restrict__ W2, const float* __restrict__ gain, int K, int Nsrc, int NP, bf16_t* __restrict__ WT,
                                                  LAS float* scr, int item, int lane) {
    const int nblk = NP / 32, kb = item / nblk, nb = item % nblk, k0 = 64 * kb, n0 = 32 * nb;
    const int n = n0 + (lane & 31);
    const float* s = W; int c;
    if (WHICH == 3) { const int t = n >> 8, r = n & 255; if (r < 128) c = 128 * t + r; else { c = 128 * t + r - 128; s = W2; } }
    else if (WHICH == 0) c = map_win(n); else if (WHICH == 1) c = map_wuq(n); else c = n;
#pragma unroll 8
    for (int i = 0; i < 32; ++i) { const int kk = 2 * i + (lane >> 5); float v = 0.f; if (c >= 0) { v = s[(size_t)(k0 + kk) * Nsrc + c]; if (gain) v *= gain[k0 + kk]; } scr[kk * 33 + (lane & 31)] = v; }
    LDS_WAIT(); asm volatile("" ::: "memory");
    const int c8 = lane & 7;
#pragma unroll
    for (int j = 0; j < 4; ++j) { const int nn = (lane >> 3) + 8 * j; const LAS float* q = scr + (8 * c8) * 33 + nn;
        u32x4 o; o.x = pk2(q[0 * 33], q[1 * 33]); o.y = pk2(q[2 * 33], q[3 * 33]); o.z = pk2(q[4 * 33], q[5 * 33]); o.w = pk2(q[6 * 33], q[7 * 33]);
        *(u32x4*)(WT + (size_t)(n0 + nn) * K + k0 + 8 * c8) = o; }
    LDS_WAIT(); asm volatile("" ::: "memory");
}

#ifndef PHMASK
#define PHMASK 0xFFFF
#endif
struct Args { const float* in[15]; float* out; unsigned char* ws; };

__global__ void __launch_bounds__(NTHREADS, 2) mega_fwd(Args args) {
    extern __shared__ __attribute__((aligned(16))) unsigned char lds_raw[];
    LAS unsigned char* lds = (LAS unsigned char*)lds_raw;
    cg::grid_group grid = cg::this_grid();
    const int tid = threadIdx.x, lane = tid & 63, wave = __builtin_amdgcn_readfirstlane(tid >> 6);
    const int G = gridDim.x, bx = blockIdx.x, vcu = (G % 8 == 0) ? (bx % 8) * (G / 8) + bx / 8 : bx;
    const int gw = vcu * NWAVES + wave, NGW = G * NWAVES;
    unsigned char* ws = args.ws;
    const float *xp = args.in[0], *xs = args.in[1], *g_mix = args.in[2], *w_in = args.in[3], *sink = args.in[4], *cq_g = args.in[5], *w_uq = args.in[6], *ckv_g = args.in[7], *w_ukv = args.in[8],
                *w_o = args.in[9], *g_ffn = args.in[10], *w_gate = args.in[11], *w_up = args.in[12], *w_down = args.in[13], *g_final = args.in[14];
    float* out = args.out;
    float *cosA = (float*)(ws + WS_COSA), *sinA = (float*)(ws + WS_SINA), *cosR = (float*)(ws + WS_COSR), *sinR = (float*)(ws + WS_SINR);
    float *rstd0 = (float*)(ws + WS_RSTD0), *SS = (float*)(ws + WS_SS);
    bf16_t *Wt_in = (bf16_t*)(ws + WS_WIN), *Wt_uq = (bf16_t*)(ws + WS_WUQ), *Wt_ukv = (bf16_t*)(ws + WS_WUKV), *Wt_o = (bf16_t*)(ws + WS_WO), *Wt_gu = (bf16_t*)(ws + WS_WGU), *Wt_down = (bf16_t*)(ws + WS_WDOWN);
    bf16_t *XB = (bf16_t*)(ws + WS_XB), *OB = (bf16_t*)(ws + WS_O), *QA = (bf16_t*)(ws + WS_QA), *KA = (bf16_t*)(ws + WS_KA), *VA = (bf16_t*)(ws + WS_VA), *CQ = (bf16_t*)(ws + WS_CQ), *CKV = (bf16_t*)(ws + WS_CKV);
    bf16_t *QB = (bf16_t*)(ws + WS_QB), *K96 = (bf16_t*)(ws + WS_K96), *VB = (bf16_t*)(ws + WS_VB), *H = (bf16_t*)(ws + WS_H), *ACT = (bf16_t*)(ws + WS_ACT);

    {
        LAS float* scr = (LAS float*)(lds + wave * 16384);
        constexpr int I_IN = (DM / 64) * (DINP / 32), I_UQ = (QRANK / 64) * (768 / 32), I_UKV = (KVRANK / 64) * (1024 / 32), I_O = (DM / 64) * (DM / 32), I_GU = (DM / 64) * (NGU / 32), I_DN = (DFF / 64) * (DM / 32);
        constexpr int NITEMS = I_IN + I_UQ + I_UKV + I_O + I_GU + I_DN;
        for (int it = gw; it < NITEMS; it += NGW) {
            int r = it;
            if (r < I_IN) { p0_transpose_item<0>(w_in, nullptr, g_mix, DM, DIN, DINP, Wt_in, scr, r, lane); continue; } r -= I_IN;
            if (r < I_UQ) { p0_transpose_item<1>(w_uq, nullptr, cq_g, QRANK, 768, 768, Wt_uq, scr, r, lane); continue; } r -= I_UQ;
            if (r < I_UKV) { p0_transpose_item<2>(w_ukv, nullptr, ckv_g, KVRANK, 1024, 1024, Wt_ukv, scr, r, lane); continue; } r -= I_UKV;
            if (r < I_O) { p0_transpose_item<2>(w_o, nullptr, nullptr, DM, DM, DM, Wt_o, scr, r, lane); continue; } r -= I_O;
            if (r < I_GU) { p0_transpose_item<3>(w_gate, w_up, g_ffn, DM, DFF, NGU, Wt_gu, scr, r, lane); continue; } r -= I_GU;
            p0_transpose_item<2>(w_down, nullptr, nullptr, DFF, DM, DM, Wt_down, scr, r, lane);
        }
        for (int i = (vcu * NTHREADS + tid); i < 8192 * 32; i += G * NTHREADS) {
            { const int pos = i >> 5, j = i & 31; const double inv = pow(10000.0, -(double)j / 32.0); const double a = (double)pos * inv; cosA[i] = (float)cos(a); sinA[i] = (float)sin(a); }
            if (i < 8192 * 16) { const int pos = i >> 4, j = i & 15; const double inv = pow(10000.0, -(double)j / 16.0); const double a = (double)pos * inv; cosR[i] = (float)cos(a); sinR[i] = (float)sin(a); }
        }
        for (int row = gw; row < M; row += NGW) {
            const float* xrow = row < MPROMPT ? xp + (size_t)row * DM : xs + (size_t)(row - MPROMPT) * DM;
            const f32x4* xr = (const f32x4*)xrow + lane;
            f32x4 v[4]; float s = 0.f;
#pragma unroll
            for (int j = 0; j < 4; ++j) { v[j] = xr[64 * j]; s += (v[j].x * v[j].x + v[j].y * v[j].y) + (v[j].z * v[j].z + v[j].w * v[j].w); }
            s = wave_sum(s);
            if (lane == 0) rstd0[row] = 1.0f / sqrtf(s * (1.0f / DM) + EPS);
            unsigned long long* o8 = (unsigned long long*)(XB + (size_t)row * DM) + lane;
#pragma unroll
            for (int j = 0; j < 4; ++j) o8[64 * j] = (unsigned long long)pk2(v[j].x, v[j].y) | ((unsigned long long)pk2(v[j].z, v[j].w) << 32);
        }
    }
    grid.sync();

#if PHMASK & 2
    { int kz = DM; asm volatile("" : "+s"(kz)); pg8::Gemm g{XB, Wt_in, M, DINP, kz}; pg8::StaticOrder S; S.init(M, DINP, G, bx);
      EpiRow8<EpiZ> E{{rstd0, cosA, sinA, cosR, sinR, QA, KA, VA, CQ, CKV, K96, SS}};
      pg8::gemm_phase<EpiRow8<EpiZ>, pg8::StaticOrder, true, true>(lds, g, S, E); }
#endif
    grid.sync();

#if PHMASK & 4
    { int kq = QRANK; asm volatile("" : "+s"(kq)); pg8::Gemm g{CQ, Wt_uq, M, 768, kq}; pg8::StaticOrder S; S.init(M, 768, G, bx);
      EpiRow8<EpiQ> E{{SS, cosR, sinR, QB}};
      pg8::gemm_phase<EpiRow8<EpiQ>, pg8::StaticOrder, true, true>(lds, g, S, E); }
#endif
#if PHMASK & 8
    { int kk = KVRANK; asm volatile("" : "+s"(kk)); pg8::Gemm g{CKV, Wt_ukv, M, 1024, kk}; pg8::StaticOrder S; S.init(M, 1024, G, bx);
      EpiRow8<EpiKV> E{{SS, K96, VB}};
      pg8::gemm_phase<EpiRow8<EpiKV>, pg8::StaticOrder, true, true>(lds, g, S, E); }
#endif
    grid.sync();

#if PHMASK & 16
    for (int it = bx; it < (M / 16) * HA; it += G) attn_naive_item<64, true>(lds, (it >> 3) * 16, it & 7, QA, 512, KA, 128, VA, 128, OB, 0, sink);
    for (int it = bx; it < (M / 16) * HB; it += G) attn_naive_item<96, false>(lds, (it >> 3) * 16, it & 7, QB, 768, K96, 768, VB, 512, OB, 512, nullptr);
#endif
    grid.sync();

#if PHMASK & 32
    { int ko = DM; asm volatile("" : "+s"(ko)); pg8::Gemm g{OB, Wt_o, M, DM, ko}; pg8::StaticOrder S; S.init(M, DM, G, bx);
      EpiRow8<EpiRes> E{{xp, xs, out}};
      pg8::gemm_phase<EpiRow8<EpiRes>, pg8::StaticOrder, true, true>(lds, g, S, E); }
#endif
    grid.sync();
    for (int row = gw; row < M; row += NGW) {
        const f32x4* xr = (const f32x4*)(out + (size_t)row * DM) + lane;
        f32x4 v[4]; float s = 0.f;
#pragma unroll
        for (int j = 0; j < 4; ++j) { v[j] = xr[64 * j]; s += (v[j].x * v[j].x + v[j].y * v[j].y) + (v[j].z * v[j].z + v[j].w * v[j].w); }
        const float r = 1.0f / sqrtf(wave_sum(s) * (1.0f / DM) + EPS);
        unsigned long long* o8 = (unsigned long long*)(H + (size_t)row * DM) + lane;
#pragma unroll
        for (int j = 0; j < 4; ++j) o8[64 * j] = (unsigned long long)pk2(v[j].x * r, v[j].y * r) | ((unsigned long long)pk2(v[j].z * r, v[j].w * r) << 32);
    }
    grid.sync();

#if PHMASK & 64
    { int kg = DM; asm volatile("" : "+s"(kg)); pg8::Gemm g{H, Wt_gu, M, NGU, kg}; pg8::StaticOrder S; S.init(M, NGU, G, bx);
      EpiDual8<EpiGU> E{{ACT}};
      pg8::gemm_phase<EpiDual8<EpiGU>, pg8::StaticOrder, true, true>(lds, g, S, E); }
#endif
    grid.sync();

#if PHMASK & 128
    { int kd = DFF; asm volatile("" : "+s"(kd)); pg8::Gemm g{ACT, Wt_down, M, DM, kd}; pg8::StaticOrder S; S.init(M, DM, G, bx);
      EpiRow8<EpiRes> E{{out, out + (size_t)MPROMPT * DM, out}};
      pg8::gemm_phase<EpiRow8<EpiRes>, pg8::StaticOrder, true, true>(lds, g, S, E); }
#endif
    grid.sync();

    for (int row = gw; row < M; row += NGW) {
        f32x4* xr = (f32x4*)(out + (size_t)row * DM) + lane; const f32x4* gr = (const f32x4*)g_final + lane;
        f32x4 v[4]; float s = 0.f;
#pragma unroll
        for (int j = 0; j < 4; ++j) { v[j] = xr[64 * j]; s += (v[j].x * v[j].x + v[j].y * v[j].y) + (v[j].z * v[j].z + v[j].w * v[j].w); }
        const float r = 1.0f / sqrtf(wave_sum(s) * (1.0f / DM) + EPS);
#pragma unroll
        for (int j = 0; j < 4; ++j) xr[64 * j] = v[j] * r * gr[64 * j];
    }
}

extern "C" void kernel_launch(void* const* d_in, const int* in_sizes, int n_in, void* d_out, int out_size, void* d_ws, size_t ws_size, hipStream_t stream) {
    static int grid = 0;
    if (grid == 0) {
        if (n_in != 15 || in_sizes[0] != MPROMPT * DM || in_sizes[1] != (M - MPROMPT) * DM || out_size != M * DM || ws_size < WS_END) {
            fprintf(stderr, "kernel_launch: unexpected shapes: n_in %d in0 %d in1 %d out %d ws %zu (need %zu)\n", n_in, n_in > 0 ? in_sizes[0] : -1, n_in > 1 ? in_sizes[1] : -1, out_size, ws_size, (size_t)WS_END);
            grid = -1; return;
        }
        int dev = 0, cus = 0, per_cu = 0;
        if (hipGetDevice(&dev) != hipSuccess || hipDeviceGetAttribute(&cus, hipDeviceAttributeMultiprocessorCount, dev) != hipSuccess) { fprintf(stderr, "kernel_launch: device query failed\n"); grid = -1; return; }
        if (hipFuncSetAttribute((const void*)mega_fwd, hipFuncAttributeMaxDynamicSharedMemorySize, LDS_BYTES) != hipSuccess) { fprintf(stderr, "kernel_launch: hipFuncSetAttribute failed\n"); grid = -1; return; }
        if (hipOccupancyMaxActiveBlocksPerMultiprocessor(&per_cu, (const void*)mega_fwd, NTHREADS, LDS_BYTES) != hipSuccess || per_cu < 1) { fprintf(stderr, "kernel_launch: occupancy query says %d blocks per CU\n", per_cu); grid = -1; return; }
        grid = cus;
    }
    if (grid < 0) return;
    Args a{};
    for (int i = 0; i < 15; ++i) a.in[i] = (const float*)d_in[i];
    a.out = (float*)d_out; a.ws = (unsigned char*)d_ws;
    void* kargs[] = {&a};
    const hipError_t e = hipLaunchCooperativeKernel((const void*)mega_fwd, dim3(grid), dim3(NTHREADS), kargs, LDS_BYTES, stream);
    if (e != hipSuccess) fprintf(stderr, "kernel_launch: cooperative launch failed: %s (grid %d)\n", hipGetErrorString(e), grid);
}
```

```cpp
#include <hip/hip_runtime.h>
#include <hip/hip_cooperative_groups.h>
#include <cstdio>
#include <cstdint>
namespace cg = cooperative_groups;

typedef unsigned short bf16_t;
typedef short bf16x8 __attribute__((ext_vector_type(8)));
typedef float f32x4 __attribute__((ext_vector_type(4)));
typedef unsigned u32x4 __attribute__((ext_vector_type(4)));
#define LAS __attribute__((address_space(3)))

constexpr int M = 49152, MPROMPT = 32768, DM = 1024;
constexpr int DIN = 1440, DINP = 1536;
constexpr int HA = 8, HB = 8, QRANK = 384, KVRANK = 256, WINDOW = 128;
constexpr int DFF = 2816, NGU = 2 * DFF;
constexpr float EPS = 1e-6f, LOG2E = 1.4426950408889634f;
constexpr float C2A = 0.125f * LOG2E;
constexpr float C2B = 0.10206207261596577f * LOG2E;

constexpr size_t MiB = 1u << 20;
constexpr size_t WS_COSA = 1 * MiB, WS_SINA = 2 * MiB, WS_COSR = 3 * MiB, WS_SINR = 3 * MiB + 512 * 1024;
constexpr size_t WS_RSTD0 = 4 * MiB;
constexpr size_t WS_WIN = 5 * MiB, WS_WUQ = 8 * MiB, WS_WUKV = 9 * MiB, WS_WO = 10 * MiB, WS_WGU = 12 * MiB, WS_WDOWN = 23 * MiB;
constexpr size_t WS_SS = 488 * MiB;
constexpr size_t WS_XB = 32 * MiB, WS_O = 32 * MiB;
constexpr size_t WS_QA = 128 * MiB, WS_KA = 176 * MiB, WS_VA = 188 * MiB, WS_CQ = 200 * MiB, WS_CKV = 236 * MiB;
constexpr size_t WS_QB = 260 * MiB, WS_K96 = 332 * MiB, WS_VB = 404 * MiB;
constexpr size_t WS_H = 128 * MiB, WS_ACT = 224 * MiB, WS_END = 493 * MiB;

__device__ __forceinline__ unsigned pk2(float lo, float hi) {
    typedef float f2 __attribute__((ext_vector_type(2))); typedef __bf16 b2 __attribute__((ext_vector_type(2)));
    f2 v = {lo, hi}; b2 b = __builtin_convertvector(v, b2); return __builtin_bit_cast(unsigned, b);
}
__device__ __forceinline__ float bf2f(unsigned h) { return __uint_as_float(h << 16); }
__device__ __forceinline__ void store8(bf16_t* p, const float* v) {
    u32x4 w; w.x = pk2(v[0], v[1]); w.y = pk2(v[2], v[3]); w.z = pk2(v[4], v[5]); w.w = pk2(v[6], v[7]); *(u32x4*)p = w;
}
__device__ __forceinline__ void row_info(int row, int& t, int& sbase, int& S) {
    if (row < MPROMPT) { S = 8192; t = row & 8191; sbase = row & ~8191; } else { S = 4096; t = row & 4095; sbase = row & ~4095; }
}
__device__ __forceinline__ float wave_sum(float v) {
#pragma unroll
    for (int o = 1; o < 64; o <<= 1) v += __shfl_xor(v, o);
    return v;
}
__device__ __forceinline__ float wave_max(float v) {
#pragma unroll
    for (int o = 1; o < 64; o <<= 1) v = fmaxf(v, __shfl_xor(v, o));
    return v;
}
__device__ __forceinline__ void rope4(float* v, const float* cs, const float* sn) {
    const f32x4 c = *(const f32x4*)cs, s = *(const f32x4*)sn;
#pragma unroll
    for (int i = 0; i < 4; ++i) { const float x1 = v[2 * i], x2 = v[2 * i + 1]; v[2 * i] = x1 * c[i] - x2 * s[i]; v[2 * i + 1] = x2 * c[i] + x1 * s[i]; }
}

__device__ __forceinline__ int map_win(int n) {
    if (n < 640) { const int hb = n & ~63, j = n & 63; return hb + (j >> 1) + 32 * (j & 1); }
    if (n < 1408) return n;
    if (n < 1440) { const int j = n - 1408; return 1408 + (j >> 1) + 16 * (j & 1); }
    return -1;
}
__device__ __forceinline__ int map_wuq(int n) { const int h = n / 96, j = n % 96; if (j < 64) return n; const int jj = j - 64; return h * 96 + 64 + (jj >> 1) + 16 * (jj & 1); }

struct EpiZ {
    const float *rstd0, *cosA, *sinA, *cosR, *sinR; bf16_t *QA, *KA, *VA, *CQ, *CKV, *K96; float* SS;
    __device__ __forceinline__ float rowscale(int row) const { return rstd0[row]; }
    __device__ __forceinline__ void operator()(int row, int c, float* v, float s) const {
        if (c >= DIN) return;
#pragma unroll
        for (int i = 0; i < 8; ++i) v[i] *= s;
        int t, sb, S; row_info(row, t, sb, S);
        if (c < 640) {
            const int j0 = (c & 63) >> 1; rope4(v, cosA + t * 32 + j0, sinA + t * 32 + j0);
            if (c < 512) {
#pragma unroll
                for (int i = 0; i < 8; ++i) v[i] *= C2A;
                store8(QA + (size_t)row * 512 + c, v);
            } else store8(KA + (size_t)row * 128 + (c - 512), v);
        } else if (c < 768) store8(VA + (size_t)row * 128 + (c - 640), v);
        else if (c < 1408) {
            float ss = 0.f;
#pragma unroll
            for (int i = 0; i < 8; ++i) ss += v[i] * v[i];
            ss += __shfl_xor(ss, 16); ss += __shfl_xor(ss, 32);
            if ((c & 31) == 0) SS[(size_t)row * 24 + ((c - 768) >> 5)] = ss;
            if (c < 1152) store8(CQ + (size_t)row * QRANK + (c - 768), v); else store8(CKV + (size_t)row * KVRANK + (c - 1152), v);
        } else {
            const int jc = c - 1408, j0 = jc >> 1; rope4(v, cosR + t * 16 + j0, sinR + t * 16 + j0);
#pragma unroll
            for (int h = 0; h < HB; ++h) store8(K96 + (size_t)row * 768 + h * 96 + 64 + jc, v);
        }
    }
};
struct EpiQ {
    const float *SS, *cosR, *sinR; bf16_t* QB;
    __device__ __forceinline__ float rowscale(int row) const {
        const f32x4* p = (const f32x4*)(SS + (size_t)row * 24); const f32x4 a = p[0], b = p[1], c = p[2];
        const float s = ((a.x + a.y) + (a.z + a.w)) + ((b.x + b.y) + (b.z + b.w)) + ((c.x + c.y) + (c.z + c.w));
        return C2B / sqrtf(s * (1.0f / QRANK) + EPS);
    }
    __device__ __forceinline__ void operator()(int row, int c, float* v, float s) const {
#pragma unroll
        for (int i = 0; i < 8; ++i) v[i] *= s;
        const int j = c % 96;
        if (j >= 64) { int t, sb, S; row_info(row, t, sb, S); const int j0 = (j - 64) >> 1; rope4(v, cosR + t * 16 + j0, sinR + t * 16 + j0); }
        store8(QB + (size_t)row * 768 + c, v);
    }
};
struct EpiKV {
    const float* SS; bf16_t *K96, *VB;
    __device__ __forceinline__ float rowscale(int row) const {
        const f32x4* p = (const f32x4*)(SS + (size_t)row * 24 + 12); const f32x4 a = p[0], b = p[1];
        const float s = ((a.x + a.y) + (a.z + a.w)) + ((b.x + b.y) + (b.z + b.w));
        return 1.0f / sqrtf(s * (1.0f / KVRANK) + EPS);
    }
    __device__ __forceinline__ void operator()(int row, int c, float* v, float s) const {
#pragma unroll
        for (int i = 0; i < 8; ++i) v[i] *= s;
        const int h = c >> 7, j = c & 127;
        if (j < 64) store8(K96 + (size_t)row * 768 + h * 96 + j, v); else store8(VB + (size_t)row * 512 + h * 64 + (j - 64), v);
    }
};
struct EpiRes {
    const float *base_p, *base_s; float* out;
    __device__ __forceinline__ float rowscale(int) const { return 1.f; }
    __device__ __forceinline__ void operator()(int row, int c, float* v, float) const {
        const float* bb = row < MPROMPT ? base_p + (size_t)row * DM : base_s + (size_t)(row - MPROMPT) * DM;
        const f32x4* b = (const f32x4*)(bb + c); f32x4* o = (f32x4*)(out + (size_t)row * DM + c);
        const f32x4 b0 = b[0], b1 = b[1];
        o[0] = (f32x4){v[0] + b0.x, v[1] + b0.y, v[2] + b0.z, v[3] + b0.w}; o[1] = (f32x4){v[4] + b1.x, v[5] + b1.y, v[6] + b1.z, v[7] + b1.w};
    }
};
struct EpiGU {
    bf16_t* ACT;
    __device__ __forceinline__ float rowscale(int) const { return 1.f; }
    __device__ __forceinline__ void operator()(int row, int c, const float* g, const float* u, float) const {
        float a[8];
#pragma unroll
        for (int i = 0; i < 8; ++i) a[i] = g[i] * __builtin_amdgcn_rcpf(1.0f + __builtin_amdgcn_exp2f(-LOG2E * g[i])) * u[i];
        store8(ACT + (size_t)row * DFF + 128 * (c >> 8) + (c & 127), a);
    }
};

namespace pg8 {
#define PG8_LAS __attribute__((address_space(3)))
typedef unsigned short bf16_t;
typedef short bf16x8 __attribute__((ext_vector_type(8)));
typedef float f32x4 __attribute__((ext_vector_type(4)));
typedef unsigned u32x4 __attribute__((ext_vector_type(4)));
constexpr int BM = 256, BK = 64, HALF = 128, HTB = HALF * BK * 2  , STAGE_BYTES = 8 * HTB, NXCD = 8, WGM = 8;

__host__ __device__ __forceinline__ int lds_byte(int r, int c) { const int st = (r >> 4) * 2 + (c >> 5), rr = r & 15, cc = c & 31, ob = rr * 64 + cc * 2; return st * 1024 + (ob ^ (((ob >> 9) & 1) << 5)); }
__host__ __device__ __forceinline__ void stage_rc(int b, int& R, int& C) { const int st = b / 1024, sb = b % 1024, swz = sb ^ (((sb >> 9) & 1) << 5); R = (st >> 1) * 16 + swz / 64; C = (st & 1) * 32 + (swz % 64) / 2; }
__host__ __device__ __forceinline__ int perm32(int rho) { const int n = rho >> 4, i = rho & 15; return 8 * (i >> 2) + 4 * n + (i & 3); }

struct Unit { int pm, pn; };
struct Gemm { const bf16_t* A; const bf16_t* Bt; int M, N, K; };

struct StaticOrder {
    int nM, nN, nwg, G, c;
    __host__ __device__ void init(int M, int N, int G_, int c_) { nM = M / BM; nN = N / BM; nwg = nM * nN; G = G_; c = c_; }
    __host__ __device__ bool next(int i, Unit& u) const {
        const long L = (long)i * G + c; if (L >= nwg) return false;
        int wgid = (int)L; { const int q = nwg / NXCD, r = nwg % NXCD, xcd = wgid % NXCD, off = wgid / NXCD; wgid = (xcd < r ? xcd * (q + 1) : r * (q + 1) + (xcd - r) * q) + off; }
        const int nig = WGM * nN, gid = wgid / nig, fm = gid * WGM, gsz = (nM - fm) < WGM ? (nM - fm) : WGM;
        u.pm = fm + ((wgid % nig) % gsz); u.pn = (wgid % nig) / gsz; return true;
    }
    __device__ __forceinline__ void a_ready(const Unit&) const {}
    __device__ __forceinline__ void done(const Unit&) const {}
};

template <class Epi, class Sched, bool ALIGN_EPI = false, bool SP2 = false>
__device__ __forceinline__ void gemm_phase(PG8_LAS unsigned char* lds, const Gemm g, const Sched& S, const Epi& E) {
    int tid_ = threadIdx.x; asm volatile("" : "+v"(tid_));
    const int tid = tid_, wid = __builtin_amdgcn_readfirstlane(tid >> 6), lane = tid & 63, wr = wid >> 2, wc = wid & 3, fr = lane & 15, fq = lane >> 4;
    const int K = g.K, nt = K / BK;
    unsigned voffA[2], voffB[2];
#pragma unroll
    for (int i = 0; i < 2; ++i) { int R, C; stage_rc(tid * 16 + i * 8192, R, C); const int Rb = Epi::PERM ? ((R & ~31) + perm32(R & 31)) : R;
        voffA[i] = (unsigned)(R * K + C) * 2u; voffB[i] = (unsigned)(Rb * K + C) * 2u; }
    const size_t kstep = (size_t)(BK * 2);
    const size_t hstep = (size_t)HALF * K * 2;
    const size_t tstep = 2 * hstep;
    const unsigned ldsw = (unsigned)wid * 1024u;
    const int aoff = lds_byte(wr * 64 + fr, fq * 8), boff = lds_byte(wc * 32 + fr, fq * 8);
#define PG8_SA(b, h) (((b) * 2 + (h)) * HTB)
#define PG8_SB(b, h) ((4 + (b) * 2 + (h)) * HTB)
#define PG8_STAGE(bufoff, gbase, voff) do { _Pragma("unroll") for (int _i = 0; _i < 2; ++_i) \
        __builtin_amdgcn_global_load_lds((const unsigned*)((const char*)(gbase) + (voff)[_i]), (PG8_LAS unsigned*)(lds + (bufoff) + ldsw + _i * 8192), 16, 0, 0); } while (0)
#define PG8_LDA(dst, b, h) do { _Pragma("unroll") for (int m = 0; m < 4; ++m) _Pragma("unroll") for (int k = 0; k < 2; ++k) dst[m][k] = *(const PG8_LAS bf16x8*)(lds + PG8_SA(b, h) + aoff + m * 2048 + k * 1024); } while (0)
#define PG8_LDB(dst, b, h) do { _Pragma("unroll") for (int n = 0; n < 2; ++n) _Pragma("unroll") for (int k = 0; k < 2; ++k) dst[n][k] = *(const PG8_LAS bf16x8*)(lds + PG8_SB(b, h) + boff + n * 2048 + k * 1024); } while (0)
#define PG8_MMA(ai, bj, At, Bt) do { __builtin_amdgcn_s_setprio(1); _Pragma("unroll") for (int m = 0; m < 4; ++m) _Pragma("unroll") for (int n = 0; n < 2; ++n) _Pragma("unroll") for (int k = 0; k < 2; ++k) \
        acc[ai][bj][m][n] = __builtin_amdgcn_mfma_f32_16x16x32_bf16(Bt[n][k], At[m][k], acc[ai][bj][m][n], 0, 0, 0); __builtin_amdgcn_s_setprio(0); } while (0)
#define PG8_WAIT_V(n) asm volatile("s_waitcnt vmcnt(" #n ")" ::: "memory")
#define PG8_WAIT_L(n) asm volatile("s_waitcnt lgkmcnt(" #n ")" ::: "memory")
#define PG8_BAR __builtin_amdgcn_s_barrier()
#define PG8_SCHED __builtin_amdgcn_sched_barrier(0)
    Unit cur, nxt; int ui = 0;
    if (!S.next(0, cur)) return;
    f32x4 acc[2][2][4][2];
#pragma unroll
    for (int a = 0; a < 2; ++a)
#pragma unroll
        for (int b = 0; b < 2; ++b)
#pragma unroll
            for (int m = 0; m < 4; ++m)
#pragma unroll
                for (int n = 0; n < 2; ++n) acc[a][b][m][n] = (f32x4){0.f, 0.f, 0.f, 0.f};
    bf16x8 At[4][2], B0[2][2], B1[2][2];
    const char* cA = (const char*)g.A + (size_t)cur.pm * tstep; const char* cB = (const char*)g.Bt + (size_t)cur.pn * tstep;
    S.a_ready(cur);
    if constexpr (SP2) {
        PG8_STAGE(PG8_SB(0, 0), cB, voffB); PG8_STAGE(PG8_SB(0, 1), cB + hstep, voffB); PG8_STAGE(PG8_SA(0, 0), cA, voffA); PG8_STAGE(PG8_SA(0, 1), cA + hstep, voffA);
        if (wr == 1) PG8_BAR;
        PG8_WAIT_V(2); PG8_BAR;
        PG8_STAGE(PG8_SB(1, 0), cB + kstep, voffB); PG8_STAGE(PG8_SA(1, 0), cA + kstep, voffA); PG8_STAGE(PG8_SB(1, 1), cB + hstep + kstep, voffB);
        PG8_WAIT_V(6); PG8_BAR;
    } else {
        PG8_STAGE(PG8_SB(0, 0), cB, voffB); PG8_STAGE(PG8_SA(0, 0), cA, voffA); PG8_STAGE(PG8_SB(0, 1), cB + hstep, voffB); PG8_STAGE(PG8_SA(0, 1), cA + hstep, voffA);
        if (wr == 1) PG8_BAR;
        PG8_WAIT_V(4); PG8_BAR;
        PG8_STAGE(PG8_SB(1, 0), cB + kstep, voffB); PG8_STAGE(PG8_SA(1, 0), cA + kstep, voffA); PG8_STAGE(PG8_SB(1, 1), cB + hstep + kstep, voffB);
        PG8_WAIT_V(6); PG8_BAR;
    }
    for (;;) {
        const bool has_next = S.next(ui + 1, nxt);
        const char* nA = has_next ? (const char*)g.A + (size_t)nxt.pm * tstep : cA; const char* nB = has_next ? (const char*)g.Bt + (size_t)nxt.pn * tstep : cB;
        for (int t = 0; t < nt; t += 2) {
            const bool last = (t == nt - 2);
            const char* a1 = cA + (size_t)(t + 1) * kstep;
            const char* a2 = last ? nA : cA + (size_t)(t + 2) * kstep; const char* b2 = last ? nB : cB + (size_t)(t + 2) * kstep;
            const char* a3 = a2 + kstep; const char* b3 = b2 + kstep;
            if (last && has_next) S.a_ready(nxt);
            if constexpr (SP2) {
            PG8_LDB(B0, 0, 0); PG8_LDB(B1, 0, 1); PG8_SCHED; PG8_LDA(At, 0, 0); PG8_STAGE(PG8_SA(1, 1), a1 + hstep, voffA);
            PG8_WAIT_V(8); PG8_WAIT_L(0); PG8_BAR; PG8_MMA(0, 0, At, B0); PG8_MMA(0, 1, At, B1); PG8_BAR; PG8_SCHED;
            PG8_LDA(At, 0, 1); PG8_STAGE(PG8_SB(0, 0), b2, voffB); PG8_STAGE(PG8_SB(0, 1), b2 + hstep, voffB); PG8_STAGE(PG8_SA(0, 0), a2, voffA);
            PG8_WAIT_V(8); PG8_WAIT_L(0); PG8_BAR; PG8_MMA(1, 0, At, B0); PG8_MMA(1, 1, At, B1); PG8_BAR; PG8_SCHED;
            PG8_LDB(B0, 1, 0); PG8_LDB(B1, 1, 1); PG8_SCHED; PG8_LDA(At, 1, 0); PG8_STAGE(PG8_SA(0, 1), a2 + hstep, voffA);
            PG8_WAIT_V(8); PG8_WAIT_L(0); PG8_BAR; PG8_MMA(0, 0, At, B0); PG8_MMA(0, 1, At, B1); PG8_BAR; PG8_SCHED;
            PG8_LDA(At, 1, 1); PG8_STAGE(PG8_SB(1, 0), b3, voffB); PG8_STAGE(PG8_SB(1, 1), b3 + hstep, voffB); PG8_STAGE(PG8_SA(1, 0), a3, voffA);
            PG8_WAIT_V(8); PG8_WAIT_L(0); PG8_BAR; PG8_MMA(1, 0, At, B0); PG8_MMA(1, 1, At, B1); PG8_BAR; PG8_SCHED;
            } else {
            PG8_LDB(B0, 0, 0); PG8_SCHED; PG8_LDA(At, 0, 0); PG8_STAGE(PG8_SA(1, 1), a1 + hstep, voffA);
            PG8_WAIT_L(8); PG8_BAR; PG8_WAIT_L(0); PG8_MMA(0, 0, At, B0); PG8_BAR; PG8_SCHED;
            PG8_LDB(B1, 0, 1); PG8_STAGE(PG8_SB(0, 0), b2, voffB);
            PG8_BAR; PG8_WAIT_L(0); PG8_MMA(0, 1, At, B1); PG8_BAR;
            PG8_LDA(At, 0, 1); PG8_STAGE(PG8_SA(0, 0), a2, voffA);
            PG8_BAR; PG8_WAIT_L(0); PG8_MMA(1, 0, At, B0); PG8_BAR; PG8_SCHED;
            PG8_STAGE(PG8_SB(0, 1), b2 + hstep, voffB);
            PG8_WAIT_V(6); PG8_BAR; PG8_MMA(1, 1, At, B1); PG8_BAR;
            PG8_LDB(B0, 1, 0); PG8_SCHED; PG8_LDA(At, 1, 0); PG8_STAGE(PG8_SA(0, 1), a2 + hstep, voffA);
            PG8_WAIT_L(8); PG8_BAR; PG8_WAIT_L(0); PG8_MMA(0, 0, At, B0); PG8_BAR; PG8_SCHED;
            PG8_LDB(B1, 1, 1); PG8_STAGE(PG8_SB(1, 0), b3, voffB);
            PG8_BAR; PG8_WAIT_L(0); PG8_MMA(0, 1, At, B1); PG8_BAR;
            PG8_LDA(At, 1, 1); PG8_STAGE(PG8_SA(1, 0), a3, voffA);
            PG8_BAR; PG8_WAIT_L(0); PG8_MMA(1, 0, At, B0); PG8_BAR; PG8_SCHED;
            PG8_STAGE(PG8_SB(1, 1), b3 + hstep, voffB);
            PG8_WAIT_V(6); PG8_BAR; PG8_MMA(1, 1, At, B1); PG8_BAR;
            }
        }
        if constexpr (ALIGN_EPI) { if (wr == 0) PG8_BAR; }
        if constexpr (!Epi::AFTER_DRAIN) { E(acc, cur, wr, wc, fr, fq); S.done(cur); }
        if (!has_next) break;
#pragma unroll
        for (int a = 0; a < 2; ++a)
#pragma unroll
            for (int b = 0; b < 2; ++b)
#pragma unroll
                for (int m = 0; m < 4; ++m)
#pragma unroll
                    for (int n = 0; n < 2; ++n) acc[a][b][m][n] = (f32x4){0.f, 0.f, 0.f, 0.f};
        cur = nxt; cA = nA; cB = nB; ++ui;
        if constexpr (ALIGN_EPI) { if (wr == 1) PG8_BAR; }
    }
    PG8_WAIT_V(0);
    if constexpr (!ALIGN_EPI) { if (wr == 0) PG8_BAR; }
    PG8_BAR;
    if constexpr (Epi::AFTER_DRAIN) { E.fused(acc, cur, wr, wc, fr, fq, lds, wid, lane); S.done(cur); }
#undef PG8_SA
#undef PG8_SB
#undef PG8_STAGE
#undef PG8_LDA
#undef PG8_LDB
#undef PG8_MMA
#undef PG8_WAIT_V
#undef PG8_WAIT_L
#undef PG8_BAR
#undef PG8_SCHED
}
}

template <class F> struct EpiRow8 {
    static constexpr bool PERM = true, AFTER_DRAIN = false; F f;
    __device__ __forceinline__ void operator()(const pg8::f32x4 (&acc)[2][2][4][2], const pg8::Unit& u, int wr, int wc, int fr, int fq) const {
        const int row0 = u.pm * 256 + wr * 64 + fr, col0 = u.pn * 256 + wc * 32 + 8 * fq;
#pragma unroll
        for (int ai = 0; ai < 2; ++ai)
#pragma unroll
            for (int m = 0; m < 4; ++m) { const int row = row0 + ai * 128 + m * 16; const float rs = f.rowscale(row);
#pragma unroll
                for (int bj = 0; bj < 2; ++bj) { const pg8::f32x4 a = acc[ai][bj][m][0], b = acc[ai][bj][m][1];
                    float v[8] = {a[0], a[1], a[2], a[3], b[0], b[1], b[2], b[3]}; f(row, col0 + bj * 128, v, rs); }
                if (m & 1) asm volatile("" ::: "memory"); }
    }
};
template <class F> struct EpiDual8 {
    static constexpr bool PERM = true, AFTER_DRAIN = false; F f;
    __device__ __forceinline__ void operator()(const pg8::f32x4 (&acc)[2][2][4][2], const pg8::Unit& u, int wr, int wc, int fr, int fq) const {
        const int row0 = u.pm * 256 + wr * 64 + fr, col0 = u.pn * 256 + wc * 32 + 8 * fq;
#pragma unroll
        for (int ai = 0; ai < 2; ++ai)
#pragma unroll
            for (int m = 0; m < 4; ++m) { const int row = row0 + ai * 128 + m * 16; const float rs = f.rowscale(row);
                const pg8::f32x4 a = acc[ai][0][m][0], b = acc[ai][0][m][1], c = acc[ai][1][m][0], d = acc[ai][1][m][1];
                const float g[8] = {a[0], a[1], a[2], a[3], b[0], b[1], b[2], b[3]}, uu[8] = {c[0], c[1], c[2], c[3], d[0], d[1], d[2], d[3]};
                f(row, col0, g, uu, rs); }
    }
};

constexpr int RING_BYTES = 131072, LDS_BYTES = 147456;
constexpr int NWAVES = 8, NTHREADS = 512;
#define LDS_WAIT() asm volatile("s_waitcnt lgkmcnt(0)" ::: "memory")

template <int DQK, bool WIN>
__device__ __forceinline__ void attn_naive_item(LAS unsigned char* lds, int r0, int h, const bf16_t* __restrict__ Q, int ldq, const bf16_t* __restrict__ Kp, int ldk,
                                                const bf16_t* __restrict__ Vp, int ldv, bf16_t* __restrict__ O, int ocol0, const float* __restrict__ sink) {
    constexpr int QT = 16, KT = 512;
    LAS float* qs = (LAS float*)lds;
    LAS float* sc = (LAS float*)(lds + QT * 96 * 4);
    LAS float* m_run = sc + QT * KT; LAS float* l_run = m_run + QT; LAS float* al = l_run + QT;
    const int tid = threadIdx.x;
    int t0, sbase, S; row_info(r0, t0, sbase, S);
    const int kvh = WIN ? (h >> 2) : h;
    for (int i = tid; i < QT * DQK; i += NTHREADS) { const int qi = i / DQK, d = i % DQK; qs[qi * DQK + d] = bf2f(Q[(size_t)(r0 + qi) * ldq + h * DQK + d]); }
    if (tid < QT) { m_run[tid] = WIN ? sink[h] * LOG2E : -1e30f; l_run[tid] = WIN ? 1.f : 0.f; }
    const int klo = WIN ? max(sbase, r0 - WINDOW) : sbase, khi = WIN ? min(sbase + S, r0 + QT + WINDOW) : sbase + S;
    float acc0 = 0.f, acc1 = 0.f; const int qi_pv = tid >> 5, dp = (tid & 31) * 2;
    __syncthreads();
    for (int kt = klo; kt < khi; kt += KT) {
        const int key = kt + tid;
        if (key < khi) {
            float kr[DQK];
            const bf16_t* kp = Kp + (size_t)key * ldk + kvh * DQK;
#pragma unroll
            for (int c = 0; c < DQK / 8; ++c) { const u32x4 w = *(const u32x4*)(kp + c * 8);
                kr[c * 8 + 0] = bf2f(w.x & 0xffffu); kr[c * 8 + 1] = bf2f(w.x >> 16); kr[c * 8 + 2] = bf2f(w.y & 0xffffu); kr[c * 8 + 3] = bf2f(w.y >> 16);
                kr[c * 8 + 4] = bf2f(w.z & 0xffffu); kr[c * 8 + 5] = bf2f(w.z >> 16); kr[c * 8 + 6] = bf2f(w.w & 0xffffu); kr[c * 8 + 7] = bf2f(w.w >> 16); }
#pragma unroll 1
            for (int qi = 0; qi < QT; ++qi) { float s = 0.f;
#pragma unroll
                for (int d = 0; d < DQK; ++d) s += qs[qi * DQK + d] * kr[d];
                if (WIN) { const int dd = (r0 + qi) - key; if (dd > WINDOW || dd < -WINDOW) s = -1e30f; }
                sc[qi * KT + tid] = s; }
        } else {
#pragma unroll 1
            for (int qi = 0; qi < QT; ++qi) sc[qi * KT + tid] = -1e30f;
        }
        __syncthreads();
        { const int w = tid >> 6, lane = tid & 63;
#pragma unroll 1
          for (int rr = 0; rr < 2; ++rr) { const int qi = 2 * w + rr; float v[8]; float mx = -1e30f;
#pragma unroll
            for (int j = 0; j < 8; ++j) { v[j] = sc[qi * KT + lane + 64 * j]; mx = fmaxf(mx, v[j]); }
            mx = wave_max(mx);
            const float mo = m_run[qi], mn = fmaxf(mo, mx), a = exp2f(mo - mn); float sm = 0.f;
#pragma unroll
            for (int j = 0; j < 8; ++j) { v[j] = exp2f(v[j] - mn); sm += v[j]; sc[qi * KT + lane + 64 * j] = v[j]; }
            sm = wave_sum(sm);
            if (lane == 0) { m_run[qi] = mn; l_run[qi] = l_run[qi] * a + sm; al[qi] = a; } } }
        __syncthreads();
        { const float a = al[qi_pv]; acc0 *= a; acc1 *= a; const int n = min(KT, khi - kt);
          const bf16_t* vp = Vp + (size_t)kt * ldv + kvh * 64 + dp;
          for (int k = 0; k < n; ++k) { const float p = sc[qi_pv * KT + k]; const unsigned vv = *(const unsigned*)(vp + (size_t)k * ldv); acc0 += p * bf2f(vv & 0xffffu); acc1 += p * bf2f(vv >> 16); } }
        __syncthreads();
    }
    const float inv = 1.0f / l_run[qi_pv];
    *(unsigned*)(O + (size_t)(r0 + qi_pv) * DM + ocol0 + h * 64 + dp) = pk2(acc0 * inv, acc1 * inv);
    __syncthreads();
}

namespace att {
using f32x16 = __attribute__((ext_vector_type(16))) float;
using s16x4 = __attribute__((ext_vector_type(4))) short;
constexpr int KCH = 1040;
constexpr int KBUF = 12 * KCH, VBUF = 8192;
constexpr int L_K = 0, L_V = 2 * KBUF, L_WS = L_V + 2 * VBUF, L_OST = L_WS + 8 * 256, L_END = L_OST + 8 * 4096;
constexpr float THR = 8.0f;
#define ATT_SBAR() __builtin_amdgcn_sched_barrier(0)
__device__ __forceinline__ int crow(int r, int hi) { return (r & 3) + 8 * (r >> 2) + 4 * hi; }

__device__ __forceinline__ void partialSM(f32x16& p0, f32x16& p1, float& m_reg, float& alpha) {
    float pmax = p0[0];
#pragma unroll
    for (int r = 1; r < 16; ++r) pmax = fmaxf(pmax, p0[r]);
#pragma unroll
    for (int r = 0; r < 16; ++r) pmax = fmaxf(pmax, p1[r]);
    { auto rr = __builtin_amdgcn_permlane32_swap(__float_as_uint(pmax), __float_as_uint(pmax), false, false); pmax = fmaxf(__uint_as_float(rr[0]), __uint_as_float(rr[1])); }
    float mn;
    if (__builtin_expect(__all(pmax - m_reg <= THR), 1)) { mn = m_reg; alpha = 1.f; }
    else { mn = fmaxf(m_reg, pmax); alpha = __builtin_amdgcn_exp2f(m_reg - mn); m_reg = mn; }
#pragma unroll
    for (int r = 0; r < 16; ++r) p0[r] -= mn;
#pragma unroll
    for (int r = 0; r < 16; ++r) p1[r] -= mn;
#pragma unroll
    for (int r = 0; r < 16; ++r) p0[r] = __builtin_amdgcn_exp2f(p0[r]);
}
__device__ __forceinline__ void finishSM(f32x16& p0, f32x16& p1, float alpha, float& l_reg, bf16x8& pa0, bf16x8& pa1, bf16x8& pa2, bf16x8& pa3) {
#pragma unroll
    for (int r = 0; r < 16; ++r) p1[r] = __builtin_amdgcn_exp2f(p1[r]);
    float ps = 0.f;
#pragma unroll
    for (int r = 0; r < 16; ++r) ps += p0[r];
#pragma unroll
    for (int r = 0; r < 16; ++r) ps += p1[r];
    { auto rr = __builtin_amdgcn_permlane32_swap(__float_as_uint(ps), __float_as_uint(ps), false, false); ps = __uint_as_float(rr[0]) + __uint_as_float(rr[1]); }
    l_reg = l_reg * alpha + ps;
#define ATT_PK4(P, BASE, OUT) do { const unsigned a0 = pk2(P[BASE + 0], P[BASE + 1]), a1 = pk2(P[BASE + 2], P[BASE + 3]), b0 = pk2(P[BASE + 4], P[BASE + 5]), b1 = pk2(P[BASE + 6], P[BASE + 7]); \
        auto r0 = __builtin_amdgcn_permlane32_swap(a0, b0, false, false); auto r1 = __builtin_amdgcn_permlane32_swap(a1, b1, false, false); \
        u32x4 w = {r0[0], r1[0], r0[1], r1[1]}; OUT = __builtin_bit_cast(bf16x8, w); } while (0)
    ATT_PK4(p0, 0, pa0); ATT_PK4(p0, 8, pa1); ATT_PK4(p1, 0, pa2); ATT_PK4(p1, 8, pa3);
#undef ATT_PK4
}
template <int DQK>
__device__ __forceinline__ void qkt(f32x16& p0, f32x16& p1, const LAS unsigned char* Kl, const bf16x8* qr, int r32, int hi) {
    p0 = f32x16{}; p1 = f32x16{};
#pragma unroll
    for (int d0 = 0; d0 < DQK / 16; ++d0) {
        const bf16x8 b0 = *(const LAS bf16x8*)(Kl + (2 * d0 + hi) * KCH + r32 * 16);
        const bf16x8 b1 = *(const LAS bf16x8*)(Kl + (2 * d0 + hi) * KCH + (32 + r32) * 16);
        p0 = __builtin_amdgcn_mfma_f32_32x32x16_bf16(b0, qr[d0], p0, 0, 0, 0);
        p1 = __builtin_amdgcn_mfma_f32_32x32x16_bf16(b1, qr[d0], p1, 0, 0, 0);
    }
}
__device__ __forceinline__ int v_st(int k, int c) { const int kk = (k & ~0xC) | ((k & 4) << 1) | ((k & 8) >> 1); return ((kk >> 3) * 2 + (c >> 5)) * 512 + ((kk & 7) * 32 + (c & 31)) * 2; }
__device__ __forceinline__ int v_rd_base(int lane) { return ((lane & 3) << 3) | (((lane >> 2) & 3) << 6) | (((lane >> 4) & 1) << 5) | (((lane >> 5) & 1) << 8); }
constexpr int v_rd_off(int d0, int ks, int half) { return d0 * 512 + ks * 2048 + half * 1024; }
template <int OFF> __device__ __forceinline__ s16x4 tr_read(int vb) { s16x4 r; asm volatile("ds_read_b64_tr_b16 %0, %1 offset:%2" : "=&v"(r) : "v"(vb), "i"(OFF) : "memory"); return r; }
template <int D0> __device__ __forceinline__ void pv_one(f32x16& od, int vb, bf16x8 pa0, bf16x8 pa1, bf16x8 pa2, bf16x8 pa3) {
    const s16x4 l0 = tr_read<v_rd_off(D0, 0, 0)>(vb), h0 = tr_read<v_rd_off(D0, 0, 1)>(vb), l1 = tr_read<v_rd_off(D0, 1, 0)>(vb), h1 = tr_read<v_rd_off(D0, 1, 1)>(vb);
    const s16x4 l2 = tr_read<v_rd_off(D0, 2, 0)>(vb), h2 = tr_read<v_rd_off(D0, 2, 1)>(vb), l3 = tr_read<v_rd_off(D0, 3, 0)>(vb), h3 = tr_read<v_rd_off(D0, 3, 1)>(vb);
    asm volatile("s_waitcnt lgkmcnt(0)" ::: "memory"); ATT_SBAR();
#define ATT_PK(L, H) (bf16x8){L[0], L[1], L[2], L[3], H[0], H[1], H[2], H[3]}
    od = __builtin_amdgcn_mfma_f32_32x32x16_bf16(pa0, ATT_PK(l0, h0), od, 0, 0, 0);
    od = __builtin_amdgcn_mfma_f32_32x32x16_bf16(pa1, ATT_PK(l1, h1), od, 0, 0, 0);
    od = __builtin_amdgcn_mfma_f32_32x32x16_bf16(pa2, ATT_PK(l2, h2), od, 0, 0, 0);
    od = __builtin_amdgcn_mfma_f32_32x32x16_bf16(pa3, ATT_PK(l3, h3), od, 0, 0, 0);
#undef ATT_PK
}
__device__ __forceinline__ void band_mask(f32x16& p0, f32x16& p1, int dq, int hi) {
#pragma unroll
    for (int r = 0; r < 16; ++r) { const int d0 = dq - crow(r, hi), d1 = d0 - 32;
        if (d0 > WINDOW || d0 < -WINDOW) p0[r] = -1e30f; if (d1 > WINDOW || d1 < -WINDOW) p1[r] = -1e30f; }
}

template <int DQK, bool WIN>
__device__ __forceinline__ void attn_unit(LAS unsigned char* lds, const bf16_t* __restrict__ Qb, int ldq, const bf16_t* __restrict__ Kh, int ldk, const bf16_t* __restrict__ Vh, int ldv,
                                          bf16_t* __restrict__ Ob, int NT, int qk0, float m0, float l0) {
    constexpr int NCH = DQK / 8, NPK = 64 * NCH;
    int tid_ = threadIdx.x; asm volatile("" : "+v"(tid_));
    const int tid = tid_, lane = tid & 63, r32 = lane & 31, hi = lane >> 5; const int wid = __builtin_amdgcn_readfirstlane(tid >> 6);
    LAS unsigned char* K_lds = lds + L_K; LAS unsigned char* V_lds = lds + L_V;
    LAS float* wsf = (LAS float*)(lds + L_WS) + wid * 64;
    float m_reg = m0, l_reg = l0; f32x16 o[2] = {}; bf16x8 qr[DQK / 16];
    const bf16_t* Qw = Qb + (size_t)(wid * 32 + r32) * ldq + hi * 8;
#pragma unroll
    for (int d0 = 0; d0 < DQK / 16; ++d0) qr[d0] = *(const bf16x8*)(Qw + d0 * 16);
    const int kk0 = tid / NCH, kc0 = tid % NCH, kk1 = (512 + tid) / NCH, kc1 = (512 + tid) % NCH;
    const bool two = (NPK > 512) && (tid < NPK - 512);
    const int kst0 = kc0 * KCH + kk0 * 16, kst1 = kc1 * KCH + kk1 * 16;
    const int vk = tid >> 3, vc = (tid & 7) * 8, vst = v_st(vk, vc);
    const int vb0 = (int)(uintptr_t)(V_lds) + v_rd_base(lane);
    struct { bf16x8 k0, k1, v; } sr_[2];
#define ATT_SLOAD(i, kb) do { sr_[i].k0 = *(const bf16x8*)(Kh + (size_t)((kb) + kk0) * ldk + kc0 * 8); if (two) sr_[i].k1 = *(const bf16x8*)(Kh + (size_t)((kb) + kk1) * ldk + kc1 * 8); \
        sr_[i].v = *(const bf16x8*)(Vh + (size_t)((kb) + vk) * ldv + vc); } while (0)
#define ATT_SWRITE(b, i) do { *(LAS bf16x8*)(K_lds + (b) * KBUF + kst0) = sr_[i].k0; if (two) *(LAS bf16x8*)(K_lds + (b) * KBUF + kst1) = sr_[i].k1; \
        *(LAS bf16x8*)(V_lds + (b) * VBUF + vst) = sr_[i].v; } while (0)
#define ATT_RESC(a) do { if (__any((a) < 1.f)) { if (hi == 0) wsf[r32] = (a); asm volatile("s_waitcnt lgkmcnt(0)" ::: "memory"); \
        _Pragma("unroll") for (int d = 0; d < 2; ++d) _Pragma("unroll") for (int r = 0; r < 16; ++r) o[d][r] *= wsf[crow(r, hi)]; } } while (0)
#define ATT_MASK(P0, P1, t) do { if (WIN) band_mask(P0, P1, qk0 + wid * 32 + r32 - (t) * 64, hi); } while (0)
    f32x16 pA0, pA1, pB0, pB1; float alA, alB; bf16x8 pa0, pa1, pa2, pa3;
    ATT_SLOAD(0, 0); asm volatile("s_waitcnt vmcnt(0)" ::: "memory"); ATT_SWRITE(0, 0); __syncthreads();
    qkt<DQK>(pA0, pA1, K_lds, qr, r32, hi); ATT_MASK(pA0, pA1, 0); partialSM(pA0, pA1, m_reg, alA);
    ATT_SLOAD(1, 64); if (2 < NT) ATT_SLOAD(0, 128);
    ATT_SWRITE(1, 1); __syncthreads();
    for (int j = 1; j + 1 < NT; j += 2) {
        ATT_SBAR(); qkt<DQK>(pB0, pB1, K_lds + KBUF, qr, r32, hi); ATT_MASK(pB0, pB1, j);
        finishSM(pA0, pA1, alA, l_reg, pa0, pa1, pa2, pa3); ATT_SBAR();
        ATT_SLOAD(1, (j + 2) * 64); ATT_SBAR();
        pv_one<0>(o[0], vb0, pa0, pa1, pa2, pa3); pv_one<1>(o[1], vb0, pa0, pa1, pa2, pa3); partialSM(pB0, pB1, m_reg, alB);
        __syncthreads(); ATT_SWRITE(0, 0);
        ATT_RESC(alB); __syncthreads();
        ATT_SBAR(); qkt<DQK>(pA0, pA1, K_lds, qr, r32, hi); ATT_MASK(pA0, pA1, j + 1);
        finishSM(pB0, pB1, alB, l_reg, pa0, pa1, pa2, pa3); ATT_SBAR();
        if (j + 3 < NT) ATT_SLOAD(0, (j + 3) * 64); ATT_SBAR();
        pv_one<0>(o[0], vb0 + VBUF, pa0, pa1, pa2, pa3); pv_one<1>(o[1], vb0 + VBUF, pa0, pa1, pa2, pa3); partialSM(pA0, pA1, m_reg, alA);
        __syncthreads(); ATT_SWRITE(1, 1);
        ATT_RESC(alA); __syncthreads();
    }
    ATT_SBAR(); qkt<DQK>(pB0, pB1, K_lds + KBUF, qr, r32, hi); ATT_MASK(pB0, pB1, NT - 1);
    finishSM(pA0, pA1, alA, l_reg, pa0, pa1, pa2, pa3); ATT_SBAR();
    pv_one<0>(o[0], vb0, pa0, pa1, pa2, pa3); pv_one<1>(o[1], vb0, pa0, pa1, pa2, pa3); partialSM(pB0, pB1, m_reg, alB);
    __syncthreads(); ATT_RESC(alB);
    finishSM(pB0, pB1, alB, l_reg, pa0, pa1, pa2, pa3); ATT_SBAR();
    pv_one<0>(o[0], vb0 + VBUF, pa0, pa1, pa2, pa3); pv_one<1>(o[1], vb0 + VBUF, pa0, pa1, pa2, pa3);
    if (hi == 0) wsf[32 + r32] = l_reg; asm volatile("s_waitcnt lgkmcnt(0)" ::: "memory");
    float rli[16];
#pragma unroll
    for (int r = 0; r < 16; ++r) rli[r] = __builtin_amdgcn_rcpf(wsf[32 + crow(r, hi)]);
    { LAS bf16_t* stg = (LAS bf16_t*)(lds + L_OST) + wid * 2048;
#pragma unroll
      for (int r = 0; r < 16; ++r) { const int orow = crow(r, hi);
#pragma unroll
        for (int d0 = 0; d0 < 2; ++d0) stg[orow * 64 + d0 * 32 + r32] = (bf16_t)(pk2(o[d0][r] * rli[r], 0.f) & 0xffffu); }
      asm volatile("s_waitcnt lgkmcnt(0)" ::: "memory");
      bf16_t* Ow = Ob + (size_t)(wid * 32) * DM;
#pragma unroll
      for (int i = 0; i < 4; ++i) { const int row = i * 8 + (lane >> 3), ch = lane & 7; const u32x4 v = *(const LAS u32x4*)(stg + row * 64 + ch * 8); *(u32x4*)(Ow + (size_t)row * DM + ch * 8) = v; } }
    __syncthreads();
#undef ATT_SLOAD
#undef ATT_SWRITE
#undef ATT_RESC
#undef ATT_MASK
}
#undef ATT_SBAR
}

template <int WHICH>
__device__ __forceinline__ void p0_transpose_item(const float* __restrict__ W, const float* __restrict__ W2, const float* __restrict__ gain, int K, int Nsrc, int NP, bf16_t* __restrict__ WT,
                                                  LAS float* scr, int item, int lane) {
    const int nblk = NP / 32, kb = item / nblk, nb = item % nblk, k0 = 64 * kb, n0 = 32 * nb;
    const int n = n0 + (lane & 31);
    const float* s = W; int c;
    if (WHICH == 3) { const int t = n >> 8, r = n & 255; if (r < 128) c = 128 * t + r; else { c = 128 * t + r - 128; s = W2; } }
    else if (WHICH == 0) c = map_win(n); else if (WHICH == 1) c = map_wuq(n); else c = n;
#pragma unroll 8
    for (int i = 0; i < 32; ++i) { const int kk = 2 * i + (lane >> 5); float v = 0.f; if (c >= 0) { v = s[(size_t)(k0 + kk) * Nsrc + c]; if (gain) v *= gain[k0 + kk]; } scr[kk * 33 + (lane & 31)] = v; }
    LDS_WAIT(); asm volatile("" ::: "memory");
    const int c8 = lane & 7;
#pragma unroll
    for (int j = 0; j < 4; ++j) { const int nn = (lane >> 3) + 8 * j; const LAS float* q = scr + (8 * c8) * 33 + nn;
        u32x4 o; o.x = pk2(q[0 * 33], q[1 * 33]); o.y = pk2(q[2 * 33], q[3 * 33]); o.z = pk2(q[4 * 33], q[5 * 33]); o.w = pk2(q[6 * 33], q[7 * 33]);
        *(u32x4*)(WT + (size_t)(n0 + nn) * K + k0 + 8 * c8) = o; }
    LDS_WAIT(); asm volatile("" ::: "memory");
}

#ifndef PHMASK
#define PHMASK 0xFFFF
#endif
struct Args { const float* in[15]; float* out; unsigned char* ws; };

__global__ void __launch_bounds__(NTHREADS, 2) mega_fwd(Args args) {
    extern __shared__ __attribute__((aligned(16))) unsigned char lds_raw[];
    LAS unsigned char* lds = (LAS unsigned char*)lds_raw;
    cg::grid_group grid = cg::this_grid();
    const int tid = threadIdx.x, lane = tid & 63, wave = __builtin_amdgcn_readfirstlane(tid >> 6);
    const int G = gridDim.x, bx = blockIdx.x, vcu = (G % 8 == 0) ? (bx % 8) * (G / 8) + bx / 8 : bx;
    const int gw = vcu * NWAVES + wave, NGW = G * NWAVES;
    unsigned char* ws = args.ws;
    const float *xp = args.in[0], *xs = args.in[1], *g_mix = args.in[2], *w_in = args.in[3], *sink = args.in[4], *cq_g = args.in[5], *w_uq = args.in[6], *ckv_g = args.in[7], *w_ukv = args.in[8],
                *w_o = args.in[9], *g_ffn = args.in[10], *w_gate = args.in[11], *w_up = args.in[12], *w_down = args.in[13], *g_final = args.in[14];
    float* out = args.out;
    float *cosA = (float*)(ws + WS_COSA), *sinA = (float*)(ws + WS_SINA), *cosR = (float*)(ws + WS_COSR), *sinR = (float*)(ws + WS_SINR);
    float *rstd0 = (float*)(ws + WS_RSTD0), *SS = (float*)(ws + WS_SS);
    bf16_t *Wt_in = (bf16_t*)(ws + WS_WIN), *Wt_uq = (bf16_t*)(ws + WS_WUQ), *Wt_ukv = (bf16_t*)(ws + WS_WUKV), *Wt_o = (bf16_t*)(ws + WS_WO), *Wt_gu = (bf16_t*)(ws + WS_WGU), *Wt_down = (bf16_t*)(ws + WS_WDOWN);
    bf16_t *XB = (bf16_t*)(ws + WS_XB), *OB = (bf16_t*)(ws + WS_O), *QA = (bf16_t*)(ws + WS_QA), *KA = (bf16_t*)(ws + WS_KA), *VA = (bf16_t*)(ws + WS_VA), *CQ = (bf16_t*)(ws + WS_CQ), *CKV = (bf16_t*)(ws + WS_CKV);
    bf16_t *QB = (bf16_t*)(ws + WS_QB), *K96 = (bf16_t*)(ws + WS_K96), *VB = (bf16_t*)(ws + WS_VB), *H = (bf16_t*)(ws + WS_H), *ACT = (bf16_t*)(ws + WS_ACT);

    {
        LAS float* scr = (LAS float*)(lds + wave * 16384);
        constexpr int I_IN = (DM / 64) * (DINP / 32), I_UQ = (QRANK / 64) * (768 / 32), I_UKV = (KVRANK / 64) * (1024 / 32), I_O = (DM / 64) * (DM / 32), I_GU = (DM / 64) * (NGU / 32), I_DN = (DFF / 64) * (DM / 32);
        constexpr int NITEMS = I_IN + I_UQ + I_UKV + I_O + I_GU + I_DN;
        for (int it = gw; it < NITEMS; it += NGW) {
            int r = it;
            if (r < I_IN) { p0_transpose_item<0>(w_in, nullptr, g_mix, DM, DIN, DINP, Wt_in, scr, r, lane); continue; } r -= I_IN;
            if (r < I_UQ) { p0_transpose_item<1>(w_uq, nullptr, cq_g, QRANK, 768, 768, Wt_uq, scr, r, lane); continue; } r -= I_UQ;
            if (r < I_UKV) { p0_transpose_item<2>(w_ukv, nullptr, ckv_g, KVRANK, 1024, 1024, Wt_ukv, scr, r, lane); continue; } r -= I_UKV;
            if (r < I_O) { p0_transpose_item<2>(w_o, nullptr, nullptr, DM, DM, DM, Wt_o, scr, r, lane); continue; } r -= I_O;
            if (r < I_GU) { p0_transpose_item<3>(w_gate, w_up, g_ffn, DM, DFF, NGU, Wt_gu, scr, r, lane); continue; } r -= I_GU;
            p0_transpose_item<2>(w_down, nullptr, nullptr, DFF, DM, DM, Wt_down, scr, r, lane);
        }
        for (int i = (vcu * NTHREADS + tid); i < 8192 * 32; i += G * NTHREADS) {
            { const int pos = i >> 5, j = i & 31; const double inv = pow(10000.0, -(double)j / 32.0); const double a = (double)pos * inv; cosA[i] = (float)cos(a); sinA[i] = (float)sin(a); }
            if (i < 8192 * 16) { const int pos = i >> 4, j = i & 15; const double inv = pow(10000.0, -(double)j / 16.0); const double a = (double)pos * inv; cosR[i] = (float)cos(a); sinR[i] = (float)sin(a); }
        }
        for (int row = gw; row < M; row += NGW) {
            const float* xrow = row < MPROMPT ? xp + (size_t)row * DM : xs + (size_t)(row - MPROMPT) * DM;
            const f32x4* xr = (const f32x4*)xrow + lane;
            f32x4 v[4]; float s = 0.f;
#pragma unroll
            for (int j = 0; j < 4; ++j) { v[j] = xr[64 * j]; s += (v[j].x * v[j].x + v[j].y * v[j].y) + (v[j].z * v[j].z + v[j].w * v[j].w); }
            s = wave_sum(s);
            if (lane == 0) rstd0[row] = 1.0f / sqrtf(s * (1.0f / DM) + EPS);
            unsigned long long* o8 = (unsigned long long*)(XB + (size_t)row * DM) + lane;
#pragma unroll
            for (int j = 0; j < 4; ++j) o8[64 * j] = (unsigned long long)pk2(v[j].x, v[j].y) | ((unsigned long long)pk2(v[j].z, v[j].w) << 32);
        }
    }
    grid.sync();

#if PHMASK & 2
    { int kz = DM; asm volatile("" : "+s"(kz)); pg8::Gemm g{XB, Wt_in, M, DINP, kz}; pg8::StaticOrder S; S.init(M, DINP, G, bx);
      EpiRow8<EpiZ> E{{rstd0, cosA, sinA, cosR, sinR, QA, KA, VA, CQ, CKV, K96, SS}};
      pg8::gemm_phase<EpiRow8<EpiZ>, pg8::StaticOrder, true, true>(lds, g, S, E); }
#endif
    grid.sync();

#if PHMASK & 4
    { int kq = QRANK; asm volatile("" : "+s"(kq)); pg8::Gemm g{CQ, Wt_uq, M, 768, kq}; pg8::StaticOrder S; S.init(M, 768, G, bx);
      EpiRow8<EpiQ> E{{SS, cosR, sinR, QB}};
      pg8::gemm_phase<EpiRow8<EpiQ>, pg8::StaticOrder, true, true>(lds, g, S, E); }
#endif
#if PHMASK & 8
    { int kk = KVRANK; asm volatile("" : "+s"(kk)); pg8::Gemm g{CKV, Wt_ukv, M, 1024, kk}; pg8::StaticOrder S; S.init(M, 1024, G, bx);
      EpiRow8<EpiKV> E{{SS, K96, VB}};
      pg8::gemm_phase<EpiRow8<EpiKV>, pg8::StaticOrder, true, true>(lds, g, S, E); }
#endif
    grid.sync();

#if PHMASK & 16
#ifdef ATTN_NAIVE
    for (int it = bx; it < (M / 16) * HA; it += G) attn_naive_item<64, true>(lds, (it >> 3) * 16, it & 7, QA, 512, KA, 128, VA, 128, OB, 0, sink);
    for (int it = bx; it < (M / 16) * HB; it += G) attn_naive_item<96, false>(lds, (it >> 3) * 16, it & 7, QB, 768, K96, 768, VB, 512, OB, 512, nullptr);
#else
    for (int w = vcu; w < 12 * 256; w += G) {
        const int r = w >> 8, v = w & 255;
        if (r < 4) {
            const int bh = (v >> 5) * 4 + r, qb = v & 31, b = bh >> 3, h = bh & 7; const size_t q0 = (size_t)b * 8192 + qb * 256, sb = (size_t)b * 8192;
            att::attn_unit<96, false>(lds, QB + q0 * 768 + h * 96, 768, K96 + sb * 768 + h * 96, 768, VB + sb * 512 + h * 64, 512, OB + q0 * DM + 512 + h * 64, 128, 0, -1e30f, 0.f);
        } else if (r < 6) {
            const int idx = (v & 31) + 32 * (r - 4), bh = (v >> 5) * 4 + (idx >> 4), qb = idx & 15, b = bh >> 3, h = bh & 7; const size_t sb = (size_t)MPROMPT + (size_t)b * 4096, q0 = sb + qb * 256;
            att::attn_unit<96, false>(lds, QB + q0 * 768 + h * 96, 768, K96 + sb * 768 + h * 96, 768, VB + sb * 512 + h * 64, 512, OB + q0 * DM + 512 + h * 64, 64, 0, -1e30f, 0.f);
        } else {
            const int u = v * 6 + (r - 6), rb = u >> 3, h = u & 7, q0 = rb * 256; int t, sb, S; row_info(q0, t, sb, S);
            const int ks = max(sb, q0 - WINDOW), ke = min(sb + S, q0 + 256 + WINDOW);
            att::attn_unit<64, true>(lds, QA + (size_t)q0 * 512 + h * 64, 512, KA + (size_t)ks * 128 + (h >> 2) * 64, 128, VA + (size_t)ks * 128 + (h >> 2) * 64, 128, OB + (size_t)q0 * DM + h * 64,
                                     (ke - ks) >> 6, q0 - ks, sink[h] * LOG2E, 1.f);
        }
    }
#endif
#endif
    grid.sync();

#if PHMASK & 32
    { int ko = DM; asm volatile("" : "+s"(ko)); pg8::Gemm g{OB, Wt_o, M, DM, ko}; pg8::StaticOrder S; S.init(M, DM, G, bx);
      EpiRow8<EpiRes> E{{xp, xs, out}};
      pg8::gemm_phase<EpiRow8<EpiRes>, pg8::StaticOrder, true, true>(lds, g, S, E); }
#endif
    grid.sync();
    for (int row = gw; row < M; row += NGW) {
        const f32x4* xr = (const f32x4*)(out + (size_t)row * DM) + lane;
        f32x4 v[4]; float s = 0.f;
#pragma unroll
        for (int j = 0; j < 4; ++j) { v[j] = xr[64 * j]; s += (v[j].x * v[j].x + v[j].y * v[j].y) + (v[j].z * v[j].z + v[j].w * v[j].w); }
        const float r = 1.0f / sqrtf(wave_sum(s) * (1.0f / DM) + EPS);
        unsigned long long* o8 = (unsigned long long*)(H + (size_t)row * DM) + lane;
#pragma unroll
        for (int j = 0; j < 4; ++j) o8[64 * j] = (unsigned long long)pk2(v[j].x * r, v[j].y * r) | ((unsigned long long)pk2(v[j].z * r, v[j].w * r) << 32);
    }
    grid.sync();

#if PHMASK & 64
    { int kg = DM; asm volatile("" : "+s"(kg)); pg8::Gemm g{H, Wt_gu, M, NGU, kg}; pg8::StaticOrder S; S.init(M, NGU, G, bx);
      EpiDual8<EpiGU> E{{ACT}};
      pg8::gemm_phase<EpiDual8<EpiGU>, pg8::StaticOrder, true, true>(lds, g, S, E); }
#endif
    grid.sync();

#if PHMASK & 128
    { int kd = DFF; asm volatile("" : "+s"(kd)); pg8::Gemm g{ACT, Wt_down, M, DM, kd}; pg8::StaticOrder S; S.init(M, DM, G, bx);
      EpiRow8<EpiRes> E{{out, out + (size_t)MPROMPT * DM, out}};
      pg8::gemm_phase<EpiRow8<EpiRes>, pg8::StaticOrder, true, true>(lds, g, S, E); }
#endif
    grid.sync();

    for (int row = gw; row < M; row += NGW) {
        f32x4* xr = (f32x4*)(out + (size_t)row * DM) + lane; const f32x4* gr = (const f32x4*)g_final + lane;
        f32x4 v[4]; float s = 0.f;
#pragma unroll
        for (int j = 0; j < 4; ++j) { v[j] = xr[64 * j]; s += (v[j].x * v[j].x + v[j].y * v[j].y) + (v[j].z * v[j].z + v[j].w * v[j].w); }
        const float r = 1.0f / sqrtf(wave_sum(s) * (1.0f / DM) + EPS);
#pragma unroll
        for (int j = 0; j < 4; ++j) xr[64 * j] = v[j] * r * gr[64 * j];
    }
}

extern "C" void kernel_launch(void* const* d_in, const int* in_sizes, int n_in, void* d_out, int out_size, void* d_ws, size_t ws_size, hipStream_t stream) {
    static int grid = 0;
    if (grid == 0) {
        if (n_in != 15 || in_sizes[0] != MPROMPT * DM || in_sizes[1] != (M - MPROMPT) * DM || out_size != M * DM || ws_size < WS_END) {
            fprintf(stderr, "kernel_launch: unexpected shapes: n_in %d in0 %d in1 %d out %d ws %zu (need %zu)\n", n_in, n_in > 0 ? in_sizes[0] : -1, n_in > 1 ? in_sizes[1] : -1, out_size, ws_size, (size_t)WS_END);
            grid = -1; return;
        }
        int dev = 0, cus = 0, per_cu = 0;
        if (hipGetDevice(&dev) != hipSuccess || hipDeviceGetAttribute(&cus, hipDeviceAttributeMultiprocessorCount, dev) != hipSuccess) { fprintf(stderr, "kernel_launch: device query failed\n"); grid = -1; return; }
        if (hipFuncSetAttribute((const void*)mega_fwd, hipFuncAttributeMaxDynamicSharedMemorySize, LDS_BYTES) != hipSuccess) { fprintf(stderr, "kernel_launch: hipFuncSetAttribute failed\n"); grid = -1; return; }
        if (hipOccupancyMaxActiveBlocksPerMultiprocessor(&per_cu, (const void*)mega_fwd, NTHREADS, LDS_BYTES) != hipSuccess || per_cu < 1) { fprintf(stderr, "kernel_launch: occupancy query says %d blocks per CU\n", per_cu); grid = -1; return; }
        grid = cus;
    }
    if (grid < 0) return;
    Args a{};
    for (int i = 0; i < 15; ++i) a.in[i] = (const float*)d_in[i];
    a.out = (float*)d_out; a.ws = (unsigned char*)d_ws;
    void* kargs[] = {&a};
    const hipError_t e = hipLaunchCooperativeKernel((const void*)mega_fwd, dim3(grid), dim3(NTHREADS), kargs, LDS_BYTES, stream);
    if (e != hipSuccess) fprintf(stderr, "kernel_launch: cooperative launch failed: %s (grid %d)\n", hipGetErrorString(e), grid);
}
```

```cpp
#include <hip/hip_runtime.h>
#include <hip/hip_cooperative_groups.h>
#include <cstdio>
#include <cstdint>
namespace cg = cooperative_groups;

typedef unsigned short bf16_t;
typedef short bf16x8 __attribute__((ext_vector_type(8)));
typedef float f32x4 __attribute__((ext_vector_type(4)));
typedef unsigned u32x4 __attribute__((ext_vector_type(4)));
#define LAS __attribute__((address_space(3)))

constexpr int M = 49152, MPROMPT = 32768, DM = 1024;
constexpr int DIN = 1440, DINP = 1536;
constexpr int HA = 8, HB = 8, QRANK = 384, KVRANK = 256, WINDOW = 128;
constexpr int DFF = 2816, NGU = 2 * DFF;
constexpr float EPS = 1e-6f, LOG2E = 1.4426950408889634f;
constexpr float C2A = 0.125f * LOG2E;
constexpr float C2B = 0.10206207261596577f * LOG2E;

constexpr size_t MiB = 1u << 20;
constexpr size_t WS_CTL = 0, CTL_ZERO_BYTES = 128 * 1024;
constexpr int CW_BAR = 1024;
constexpr size_t WS_COSA = 1 * MiB, WS_SINA = 2 * MiB, WS_COSR = 3 * MiB, WS_SINR = 3 * MiB + 512 * 1024;
constexpr size_t WS_RSTD0 = 4 * MiB;
constexpr size_t WS_WIN = 5 * MiB, WS_WUQ = 8 * MiB, WS_WUKV = 9 * MiB, WS_WO = 10 * MiB, WS_WGU = 12 * MiB, WS_WDOWN = 23 * MiB;
constexpr size_t WS_SS = 488 * MiB;
constexpr size_t WS_XB = 32 * MiB, WS_O = 32 * MiB;
constexpr size_t WS_QA = 128 * MiB, WS_KA = 176 * MiB, WS_VA = 188 * MiB, WS_CQ = 200 * MiB, WS_CKV = 236 * MiB;
constexpr size_t WS_QB = 260 * MiB, WS_K96 = 332 * MiB, WS_VB = 404 * MiB;
constexpr size_t WS_H = 128 * MiB, WS_ACT = 224 * MiB, WS_END = 493 * MiB;

__device__ __forceinline__ unsigned pk2(float lo, float hi) {
    typedef float f2 __attribute__((ext_vector_type(2))); typedef __bf16 b2 __attribute__((ext_vector_type(2)));
    f2 v = {lo, hi}; b2 b = __builtin_convertvector(v, b2); return __builtin_bit_cast(unsigned, b);
}
__device__ __forceinline__ float bf2f(unsigned h) { return __uint_as_float(h << 16); }
__device__ __forceinline__ void store8(bf16_t* p, const float* v) {
    u32x4 w; w.x = pk2(v[0], v[1]); w.y = pk2(v[2], v[3]); w.z = pk2(v[4], v[5]); w.w = pk2(v[6], v[7]); *(u32x4*)p = w;
}
__device__ __forceinline__ void row_info(int row, int& t, int& sbase, int& S) {
    if (row < MPROMPT) { S = 8192; t = row & 8191; sbase = row & ~8191; } else { S = 4096; t = row & 4095; sbase = row & ~4095; }
}
__device__ __forceinline__ float wave_sum(float v) {
#pragma unroll
    for (int o = 1; o < 64; o <<= 1) v += __shfl_xor(v, o);
    return v;
}
__device__ __forceinline__ float wave_max(float v) {
#pragma unroll
    for (int o = 1; o < 64; o <<= 1) v = fmaxf(v, __shfl_xor(v, o));
    return v;
}
__device__ __forceinline__ void rope4(float* v, const float* cs, const float* sn) {
    const f32x4 c = *(const f32x4*)cs, s = *(const f32x4*)sn;
#pragma unroll
    for (int i = 0; i < 4; ++i) { const float x1 = v[2 * i], x2 = v[2 * i + 1]; v[2 * i] = x1 * c[i] - x2 * s[i]; v[2 * i + 1] = x2 * c[i] + x1 * s[i]; }
}

__device__ __forceinline__ int map_win(int n) {
    if (n < 640) { const int hb = n & ~63, j = n & 63; return hb + (j >> 1) + 32 * (j & 1); }
    if (n < 1408) return n;
    if (n < 1440) { const int j = n - 1408; return 1408 + (j >> 1) + 16 * (j & 1); }
    return -1;
}
__device__ __forceinline__ int map_wuq(int n) { const int h = n / 96, j = n % 96; if (j < 64) return n; const int jj = j - 64; return h * 96 + 64 + (jj >> 1) + 16 * (jj & 1); }

struct EpiZ {
    const float *rstd0, *cosA, *sinA, *cosR, *sinR; bf16_t *QA, *KA, *VA, *CQ, *CKV, *K96; float* SS;
    __device__ __forceinline__ float rowscale(int row) const { return rstd0[row]; }
    __device__ __forceinline__ void operator()(int row, int c, float* v, float s) const {
        if (c >= DIN) return;
#pragma unroll
        for (int i = 0; i < 8; ++i) v[i] *= s;
        int t, sb, S; row_info(row, t, sb, S);
        if (c < 640) {
            const int j0 = (c & 63) >> 1; rope4(v, cosA + t * 32 + j0, sinA + t * 32 + j0);
            if (c < 512) {
#pragma unroll
                for (int i = 0; i < 8; ++i) v[i] *= C2A;
                store8(QA + (size_t)row * 512 + c, v);
            } else store8(KA + (size_t)row * 128 + (c - 512), v);
        } else if (c < 768) store8(VA + (size_t)row * 128 + (c - 640), v);
        else if (c < 1408) {
            float ss = 0.f;
#pragma unroll
            for (int i = 0; i < 8; ++i) ss += v[i] * v[i];
            ss += __shfl_xor(ss, 16); ss += __shfl_xor(ss, 32);
            if ((c & 31) == 0) SS[(size_t)row * 24 + ((c - 768) >> 5)] = ss;
            if (c < 1152) store8(CQ + (size_t)row * QRANK + (c - 768), v); else store8(CKV + (size_t)row * KVRANK + (c - 1152), v);
        } else {
            const int jc = c - 1408, j0 = jc >> 1; rope4(v, cosR + t * 16 + j0, sinR + t * 16 + j0);
#pragma unroll
            for (int h = 0; h < HB; ++h) store8(K96 + (size_t)row * 768 + h * 96 + 64 + jc, v);
        }
    }
};
struct EpiQ {
    const float *SS, *cosR, *sinR; bf16_t* QB;
    __device__ __forceinline__ float rowscale(int row) const {
        const f32x4* p = (const f32x4*)(SS + (size_t)row * 24); const f32x4 a = p[0], b = p[1], c = p[2];
        const float s = ((a.x + a.y) + (a.z + a.w)) + ((b.x + b.y) + (b.z + b.w)) + ((c.x + c.y) + (c.z + c.w));
        return C2B / sqrtf(s * (1.0f / QRANK) + EPS);
    }
    __device__ __forceinline__ void operator()(int row, int c, float* v, float s) const {
#pragma unroll
        for (int i = 0; i < 8; ++i) v[i] *= s;
        const int j = c % 96;
        if (j >= 64) { int t, sb, S; row_info(row, t, sb, S); const int j0 = (j - 64) >> 1; rope4(v, cosR + t * 16 + j0, sinR + t * 16 + j0); }
        store8(QB + (size_t)row * 768 + c, v);
    }
};
struct EpiKV {
    const float* SS; bf16_t *K96, *VB;
    __device__ __forceinline__ float rowscale(int row) const {
        const f32x4* p = (const f32x4*)(SS + (size_t)row * 24 + 12); const f32x4 a = p[0], b = p[1];
        const float s = ((a.x + a.y) + (a.z + a.w)) + ((b.x + b.y) + (b.z + b.w));
        return 1.0f / sqrtf(s * (1.0f / KVRANK) + EPS);
    }
    __device__ __forceinline__ void operator()(int row, int c, float* v, float s) const {
#pragma unroll
        for (int i = 0; i < 8; ++i) v[i] *= s;
        const int h = c >> 7, j = c & 127;
        if (j < 64) store8(K96 + (size_t)row * 768 + h * 96 + j, v); else store8(VB + (size_t)row * 512 + h * 64 + (j - 64), v);
    }
};
struct EpiRes {
    const float *base_p, *base_s; float* out;
    __device__ __forceinline__ float rowscale(int) const { return 1.f; }
    __device__ __forceinline__ void operator()(int row, int c, float* v, float) const {
        const float* bb = row < MPROMPT ? base_p + (size_t)row * DM : base_s + (size_t)(row - MPROMPT) * DM;
        const f32x4* b = (const f32x4*)(bb + c); f32x4* o = (f32x4*)(out + (size_t)row * DM + c);
        const f32x4 b0 = b[0], b1 = b[1];
        o[0] = (f32x4){v[0] + b0.x, v[1] + b0.y, v[2] + b0.z, v[3] + b0.w}; o[1] = (f32x4){v[4] + b1.x, v[5] + b1.y, v[6] + b1.z, v[7] + b1.w};
    }
};
struct EpiGU {
    bf16_t* ACT;
    __device__ __forceinline__ float rowscale(int) const { return 1.f; }
    __device__ __forceinline__ void operator()(int row, int c, const float* g, const float* u, float) const {
        float a[8];
#pragma unroll
        for (int i = 0; i < 8; ++i) a[i] = g[i] * __builtin_amdgcn_rcpf(1.0f + __builtin_amdgcn_exp2f(-LOG2E * g[i])) * u[i];
        store8(ACT + (size_t)row * DFF + 128 * (c >> 8) + (c & 127), a);
    }
};

namespace pg8 {
#define PG8_LAS __attribute__((address_space(3)))
typedef unsigned short bf16_t;
typedef short bf16x8 __attribute__((ext_vector_type(8)));
typedef float f32x4 __attribute__((ext_vector_type(4)));
typedef unsigned u32x4 __attribute__((ext_vector_type(4)));
constexpr int BM = 256, BK = 64, HALF = 128, HTB = HALF * BK * 2  , STAGE_BYTES = 8 * HTB, NXCD = 8, WGM = 8;

__host__ __device__ __forceinline__ int lds_byte(int r, int c) { const int st = (r >> 4) * 2 + (c >> 5), rr = r & 15, cc = c & 31, ob = rr * 64 + cc * 2; return st * 1024 + (ob ^ (((ob >> 9) & 1) << 5)); }
__host__ __device__ __forceinline__ void stage_rc(int b, int& R, int& C) { const int st = b / 1024, sb = b % 1024, swz = sb ^ (((sb >> 9) & 1) << 5); R = (st >> 1) * 16 + swz / 64; C = (st & 1) * 32 + (swz % 64) / 2; }
__host__ __device__ __forceinline__ int perm32(int rho) { const int n = rho >> 4, i = rho & 15; return 8 * (i >> 2) + 4 * n + (i & 3); }

struct Unit { int pm, pn; };
struct Gemm { const bf16_t* A; const bf16_t* Bt; int M, N, K; };

struct StaticOrder {
    int nM, nN, nwg, G, c;
    __host__ __device__ void init(int M, int N, int G_, int c_) { nM = M / BM; nN = N / BM; nwg = nM * nN; G = G_; c = c_; }
    __host__ __device__ bool next(int i, Unit& u) const {
        const long L = (long)i * G + c; if (L >= nwg) return false;
        int wgid = (int)L; { const int q = nwg / NXCD, r = nwg % NXCD, xcd = wgid % NXCD, off = wgid / NXCD; wgid = (xcd < r ? xcd * (q + 1) : r * (q + 1) + (xcd - r) * q) + off; }
        const int nig = WGM * nN, gid = wgid / nig, fm = gid * WGM, gsz = (nM - fm) < WGM ? (nM - fm) : WGM;
        u.pm = fm + ((wgid % nig) % gsz); u.pn = (wgid % nig) / gsz; return true;
    }
    __device__ __forceinline__ void a_ready(const Unit&) const {}
    __device__ __forceinline__ void done(const Unit&) const {}
};

template <class Epi, class Sched, bool ALIGN_EPI = false, bool SP2 = false>
__device__ __forceinline__ void gemm_phase(PG8_LAS unsigned char* lds, const Gemm g, const Sched& S, const Epi& E) {
    int tid_ = threadIdx.x; asm volatile("" : "+v"(tid_));
    const int tid = tid_, wid = __builtin_amdgcn_readfirstlane(tid >> 6), lane = tid & 63, wr = wid >> 2, wc = wid & 3, fr = lane & 15, fq = lane >> 4;
    const int K = g.K, nt = K / BK;
    unsigned voffA[2], voffB[2];
#pragma unroll
    for (int i = 0; i < 2; ++i) { int R, C; stage_rc(tid * 16 + i * 8192, R, C); const int Rb = Epi::PERM ? ((R & ~31) + perm32(R & 31)) : R;
        voffA[i] = (unsigned)(R * K + C) * 2u; voffB[i] = (unsigned)(Rb * K + C) * 2u; }
    const size_t kstep = (size_t)(BK * 2);
    const size_t hstep = (size_t)HALF * K * 2;
    const size_t tstep = 2 * hstep;
    const unsigned ldsw = (unsigned)wid * 1024u;
    const int aoff = lds_byte(wr * 64 + fr, fq * 8), boff = lds_byte(wc * 32 + fr, fq * 8);
#define PG8_SA(b, h) (((b) * 2 + (h)) * HTB)
#define PG8_SB(b, h) ((4 + (b) * 2 + (h)) * HTB)
#define PG8_STAGE(bufoff, gbase, voff) do { _Pragma("unroll") for (int _i = 0; _i < 2; ++_i) \
        __builtin_amdgcn_global_load_lds((const unsigned*)((const char*)(gbase) + (voff)[_i]), (PG8_LAS unsigned*)(lds + (bufoff) + ldsw + _i * 8192), 16, 0, 0); } while (0)
#define PG8_LDA(dst, b, h) do { _Pragma("unroll") for (int m = 0; m < 4; ++m) _Pragma("unroll") for (int k = 0; k < 2; ++k) dst[m][k] = *(const PG8_LAS bf16x8*)(lds + PG8_SA(b, h) + aoff + m * 2048 + k * 1024); } while (0)
#define PG8_LDB(dst, b, h) do { _Pragma("unroll") for (int n = 0; n < 2; ++n) _Pragma("unroll") for (int k = 0; k < 2; ++k) dst[n][k] = *(const PG8_LAS bf16x8*)(lds + PG8_SB(b, h) + boff + n * 2048 + k * 1024); } while (0)
#define PG8_MMA(ai, bj, At, Bt) do { __builtin_amdgcn_s_setprio(1); _Pragma("unroll") for (int m = 0; m < 4; ++m) _Pragma("unroll") for (int n = 0; n < 2; ++n) _Pragma("unroll") for (int k = 0; k < 2; ++k) \
        acc[ai][bj][m][n] = __builtin_amdgcn_mfma_f32_16x16x32_bf16(Bt[n][k], At[m][k], acc[ai][bj][m][n], 0, 0, 0); __builtin_amdgcn_s_setprio(0); } while (0)
#define PG8_WAIT_V(n) asm volatile("s_waitcnt vmcnt(" #n ")" ::: "memory")
#define PG8_WAIT_L(n) asm volatile("s_waitcnt lgkmcnt(" #n ")" ::: "memory")
#define PG8_BAR __builtin_amdgcn_s_barrier()
#define PG8_SCHED __builtin_amdgcn_sched_barrier(0)
    Unit cur, nxt; int ui = 0;
    if (!S.next(0, cur)) return;
    f32x4 acc[2][2][4][2];
#pragma unroll
    for (int a = 0; a < 2; ++a)
#pragma unroll
        for (int b = 0; b < 2; ++b)
#pragma unroll
            for (int m = 0; m < 4; ++m)
#pragma unroll
                for (int n = 0; n < 2; ++n) acc[a][b][m][n] = (f32x4){0.f, 0.f, 0.f, 0.f};
    bf16x8 At[4][2], B0[2][2], B1[2][2];
    const char* cA = (const char*)g.A + (size_t)cur.pm * tstep; const char* cB = (const char*)g.Bt + (size_t)cur.pn * tstep;
    S.a_ready(cur);
    if constexpr (SP2) {
        PG8_STAGE(PG8_SB(0, 0), cB, voffB); PG8_STAGE(PG8_SB(0, 1), cB + hstep, voffB); PG8_STAGE(PG8_SA(0, 0), cA, voffA); PG8_STAGE(PG8_SA(0, 1), cA + hstep, voffA);
        if (wr == 1) PG8_BAR;
        PG8_WAIT_V(2); PG8_BAR;
        PG8_STAGE(PG8_SB(1, 0), cB + kstep, voffB); PG8_STAGE(PG8_SA(1, 0), cA + kstep, voffA); PG8_STAGE(PG8_SB(1, 1), cB + hstep + kstep, voffB);
        PG8_WAIT_V(6); PG8_BAR;
    } else {
        PG8_STAGE(PG8_SB(0, 0), cB, voffB); PG8_STAGE(PG8_SA(0, 0), cA, voffA); PG8_STAGE(PG8_SB(0, 1), cB + hstep, voffB); PG8_STAGE(PG8_SA(0, 1), cA + hstep, voffA);
        if (wr == 1) PG8_BAR;
        PG8_WAIT_V(4); PG8_BAR;
        PG8_STAGE(PG8_SB(1, 0), cB + kstep, voffB); PG8_STAGE(PG8_SA(1, 0), cA + kstep, voffA); PG8_STAGE(PG8_SB(1, 1), cB + hstep + kstep, voffB);
        PG8_WAIT_V(6); PG8_BAR;
    }
    for (;;) {
        const bool has_next = S.next(ui + 1, nxt);
        const char* nA = has_next ? (const char*)g.A + (size_t)nxt.pm * tstep : cA; const char* nB = has_next ? (const char*)g.Bt + (size_t)nxt.pn * tstep : cB;
        for (int t = 0; t < nt; t += 2) {
            const bool last = (t == nt - 2);
            const char* a1 = cA + (size_t)(t + 1) * kstep;
            const char* a2 = last ? nA : cA + (size_t)(t + 2) * kstep; const char* b2 = last ? nB : cB + (size_t)(t + 2) * kstep;
            const char* a3 = a2 + kstep; const char* b3 = b2 + kstep;
            if (last && has_next) S.a_ready(nxt);
            if constexpr (SP2) {
            PG8_LDB(B0, 0, 0); PG8_LDB(B1, 0, 1); PG8_SCHED; PG8_LDA(At, 0, 0); PG8_STAGE(PG8_SA(1, 1), a1 + hstep, voffA);
            PG8_WAIT_V(8); PG8_WAIT_L(0); PG8_BAR; PG8_MMA(0, 0, At, B0); PG8_MMA(0, 1, At, B1); PG8_BAR; PG8_SCHED;
            PG8_LDA(At, 0, 1); PG8_STAGE(PG8_SB(0, 0), b2, voffB); PG8_STAGE(PG8_SB(0, 1), b2 + hstep, voffB); PG8_STAGE(PG8_SA(0, 0), a2, voffA);
            PG8_WAIT_V(8); PG8_WAIT_L(0); PG8_BAR; PG8_MMA(1, 0, At, B0); PG8_MMA(1, 1, At, B1); PG8_BAR; PG8_SCHED;
            PG8_LDB(B0, 1, 0); PG8_LDB(B1, 1, 1); PG8_SCHED; PG8_LDA(At, 1, 0); PG8_STAGE(PG8_SA(0, 1), a2 + hstep, voffA);
            PG8_WAIT_V(8); PG8_WAIT_L(0); PG8_BAR; PG8_MMA(0, 0, At, B0); PG8_MMA(0, 1, At, B1); PG8_BAR; PG8_SCHED;
            PG8_LDA(At, 1, 1); PG8_STAGE(PG8_SB(1, 0), b3, voffB); PG8_STAGE(PG8_SB(1, 1), b3 + hstep, voffB); PG8_STAGE(PG8_SA(1, 0), a3, voffA);
            PG8_WAIT_V(8); PG8_WAIT_L(0); PG8_BAR; PG8_MMA(1, 0, At, B0); PG8_MMA(1, 1, At, B1); PG8_BAR; PG8_SCHED;
            } else {
            PG8_LDB(B0, 0, 0); PG8_SCHED; PG8_LDA(At, 0, 0); PG8_STAGE(PG8_SA(1, 1), a1 + hstep, voffA);
            PG8_WAIT_L(8); PG8_BAR; PG8_WAIT_L(0); PG8_MMA(0, 0, At, B0); PG8_BAR; PG8_SCHED;
            PG8_LDB(B1, 0, 1); PG8_STAGE(PG8_SB(0, 0), b2, voffB);
            PG8_BAR; PG8_WAIT_L(0); PG8_MMA(0, 1, At, B1); PG8_BAR;
            PG8_LDA(At, 0, 1); PG8_STAGE(PG8_SA(0, 0), a2, voffA);
            PG8_BAR; PG8_WAIT_L(0); PG8_MMA(1, 0, At, B0); PG8_BAR; PG8_SCHED;
            PG8_STAGE(PG8_SB(0, 1), b2 + hstep, voffB);
            PG8_WAIT_V(6); PG8_BAR; PG8_MMA(1, 1, At, B1); PG8_BAR;
            PG8_LDB(B0, 1, 0); PG8_SCHED; PG8_LDA(At, 1, 0); PG8_STAGE(PG8_SA(0, 1), a2 + hstep, voffA);
            PG8_WAIT_L(8); PG8_BAR; PG8_WAIT_L(0); PG8_MMA(0, 0, At, B0); PG8_BAR; PG8_SCHED;
            PG8_LDB(B1, 1, 1); PG8_STAGE(PG8_SB(1, 0), b3, voffB);
            PG8_BAR; PG8_WAIT_L(0); PG8_MMA(0, 1, At, B1); PG8_BAR;
            PG8_LDA(At, 1, 1); PG8_STAGE(PG8_SA(1, 0), a3, voffA);
            PG8_BAR; PG8_WAIT_L(0); PG8_MMA(1, 0, At, B0); PG8_BAR; PG8_SCHED;
            PG8_STAGE(PG8_SB(1, 1), b3 + hstep, voffB);
            PG8_WAIT_V(6); PG8_BAR; PG8_MMA(1, 1, At, B1); PG8_BAR;
            }
        }
        if constexpr (ALIGN_EPI) { if (wr == 0) PG8_BAR; }
        if constexpr (!Epi::AFTER_DRAIN) { E(acc, cur, wr, wc, fr, fq); S.done(cur); }
        if (!has_next) break;
#pragma unroll
        for (int a = 0; a < 2; ++a)
#pragma unroll
            for (int b = 0; b < 2; ++b)
#pragma unroll
                for (int m = 0; m < 4; ++m)
#pragma unroll
                    for (int n = 0; n < 2; ++n) acc[a][b][m][n] = (f32x4){0.f, 0.f, 0.f, 0.f};
        cur = nxt; cA = nA; cB = nB; ++ui;
        if constexpr (ALIGN_EPI) { if (wr == 1) PG8_BAR; }
    }
    PG8_WAIT_V(0);
    if constexpr (!ALIGN_EPI) { if (wr == 0) PG8_BAR; }
    PG8_BAR;
    if constexpr (Epi::AFTER_DRAIN) { E.fused(acc, cur, wr, wc, fr, fq, lds, wid, lane); S.done(cur); }
#undef PG8_SA
#undef PG8_SB
#undef PG8_STAGE
#undef PG8_LDA
#undef PG8_LDB
#undef PG8_MMA
#undef PG8_WAIT_V
#undef PG8_WAIT_L
#undef PG8_BAR
#undef PG8_SCHED
}
}

template <class F> struct EpiRow8 {
    static constexpr bool PERM = true, AFTER_DRAIN = false; F f;
    __device__ __forceinline__ void operator()(const pg8::f32x4 (&acc)[2][2][4][2], const pg8::Unit& u, int wr, int wc, int fr, int fq) const {
        const int row0 = u.pm * 256 + wr * 64 + fr, col0 = u.pn * 256 + wc * 32 + 8 * fq;
#pragma unroll
        for (int ai = 0; ai < 2; ++ai)
#pragma unroll
            for (int m = 0; m < 4; ++m) { const int row = row0 + ai * 128 + m * 16; const float rs = f.rowscale(row);
#pragma unroll
                for (int bj = 0; bj < 2; ++bj) { const pg8::f32x4 a = acc[ai][bj][m][0], b = acc[ai][bj][m][1];
                    float v[8] = {a[0], a[1], a[2], a[3], b[0], b[1], b[2], b[3]}; f(row, col0 + bj * 128, v, rs); }
                if (m & 1) asm volatile("" ::: "memory"); }
    }
};
template <class F> struct EpiDual8 {
    static constexpr bool PERM = true, AFTER_DRAIN = false; F f;
    __device__ __forceinline__ void operator()(const pg8::f32x4 (&acc)[2][2][4][2], const pg8::Unit& u, int wr, int wc, int fr, int fq) const {
        const int row0 = u.pm * 256 + wr * 64 + fr, col0 = u.pn * 256 + wc * 32 + 8 * fq;
#pragma unroll
        for (int ai = 0; ai < 2; ++ai)
#pragma unroll
            for (int m = 0; m < 4; ++m) { const int row = row0 + ai * 128 + m * 16; const float rs = f.rowscale(row);
                const pg8::f32x4 a = acc[ai][0][m][0], b = acc[ai][0][m][1], c = acc[ai][1][m][0], d = acc[ai][1][m][1];
                const float g[8] = {a[0], a[1], a[2], a[3], b[0], b[1], b[2], b[3]}, uu[8] = {c[0], c[1], c[2], c[3], d[0], d[1], d[2], d[3]};
                f(row, col0, g, uu, rs); }
    }
};

constexpr int RING_BYTES = 131072, LDS_BYTES = 147456;
constexpr int NWAVES = 8, NTHREADS = 512;
#define LDS_WAIT() asm volatile("s_waitcnt lgkmcnt(0)" ::: "memory")

template <int DQK, bool WIN>
__device__ __forceinline__ void attn_naive_item(LAS unsigned char* lds, int r0, int h, const bf16_t* __restrict__ Q, int ldq, const bf16_t* __restrict__ Kp, int ldk,
                                                const bf16_t* __restrict__ Vp, int ldv, bf16_t* __restrict__ O, int ocol0, const float* __restrict__ sink) {
    constexpr int QT = 16, KT = 512;
    LAS float* qs = (LAS float*)lds;
    LAS float* sc = (LAS float*)(lds + QT * 96 * 4);
    LAS float* m_run = sc + QT * KT; LAS float* l_run = m_run + QT; LAS float* al = l_run + QT;
    const int tid = threadIdx.x;
    int t0, sbase, S; row_info(r0, t0, sbase, S);
    const int kvh = WIN ? (h >> 2) : h;
    for (int i = tid; i < QT * DQK; i += NTHREADS) { const int qi = i / DQK, d = i % DQK; qs[qi * DQK + d] = bf2f(Q[(size_t)(r0 + qi) * ldq + h * DQK + d]); }
    if (tid < QT) { m_run[tid] = WIN ? sink[h] * LOG2E : -1e30f; l_run[tid] = WIN ? 1.f : 0.f; }
    const int klo = WIN ? max(sbase, r0 - WINDOW) : sbase, khi = WIN ? min(sbase + S, r0 + QT + WINDOW) : sbase + S;
    float acc0 = 0.f, acc1 = 0.f; const int qi_pv = tid >> 5, dp = (tid & 31) * 2;
    __syncthreads();
    for (int kt = klo; kt < khi; kt += KT) {
        const int key = kt + tid;
        if (key < khi) {
            float kr[DQK];
            const bf16_t* kp = Kp + (size_t)key * ldk + kvh * DQK;
#pragma unroll
            for (int c = 0; c < DQK / 8; ++c) { const u32x4 w = *(const u32x4*)(kp + c * 8);
                kr[c * 8 + 0] = bf2f(w.x & 0xffffu); kr[c * 8 + 1] = bf2f(w.x >> 16); kr[c * 8 + 2] = bf2f(w.y & 0xffffu); kr[c * 8 + 3] = bf2f(w.y >> 16);
                kr[c * 8 + 4] = bf2f(w.z & 0xffffu); kr[c * 8 + 5] = bf2f(w.z >> 16); kr[c * 8 + 6] = bf2f(w.w & 0xffffu); kr[c * 8 + 7] = bf2f(w.w >> 16); }
#pragma unroll 1
            for (int qi = 0; qi < QT; ++qi) { float s = 0.f;
#pragma unroll
                for (int d = 0; d < DQK; ++d) s += qs[qi * DQK + d] * kr[d];
                if (WIN) { const int dd = (r0 + qi) - key; if (dd > WINDOW || dd < -WINDOW) s = -1e30f; }
                sc[qi * KT + tid] = s; }
        } else {
#pragma unroll 1
            for (int qi = 0; qi < QT; ++qi) sc[qi * KT + tid] = -1e30f;
        }
        __syncthreads();
        { const int w = tid >> 6, lane = tid & 63;
#pragma unroll 1
          for (int rr = 0; rr < 2; ++rr) { const int qi = 2 * w + rr; float v[8]; float mx = -1e30f;
#pragma unroll
            for (int j = 0; j < 8; ++j) { v[j] = sc[qi * KT + lane + 64 * j]; mx = fmaxf(mx, v[j]); }
            mx = wave_max(mx);
            const float mo = m_run[qi], mn = fmaxf(mo, mx), a = exp2f(mo - mn); float sm = 0.f;
#pragma unroll
            for (int j = 0; j < 8; ++j) { v[j] = exp2f(v[j] - mn); sm += v[j]; sc[qi * KT + lane + 64 * j] = v[j]; }
            sm = wave_sum(sm);
            if (lane == 0) { m_run[qi] = mn; l_run[qi] = l_run[qi] * a + sm; al[qi] = a; } } }
        __syncthreads();
        { const float a = al[qi_pv]; acc0 *= a; acc1 *= a; const int n = min(KT, khi - kt);
          const bf16_t* vp = Vp + (size_t)kt * ldv + kvh * 64 + dp;
          for (int k = 0; k < n; ++k) { const float p = sc[qi_pv * KT + k]; const unsigned vv = *(const unsigned*)(vp + (size_t)k * ldv); acc0 += p * bf2f(vv & 0xffffu); acc1 += p * bf2f(vv >> 16); } }
        __syncthreads();
    }
    const float inv = 1.0f / l_run[qi_pv];
    *(unsigned*)(O + (size_t)(r0 + qi_pv) * DM + ocol0 + h * 64 + dp) = pk2(acc0 * inv, acc1 * inv);
    __syncthreads();
}

namespace att {
using f32x16 = __attribute__((ext_vector_type(16))) float;
using s16x4 = __attribute__((ext_vector_type(4))) short;
constexpr int KCH = 1040;
constexpr int KBUF = 12 * KCH, VBUF = 8192;
constexpr int L_K = 0, L_V = 2 * KBUF, L_WS = L_V + 2 * VBUF, L_OST = L_WS + 8 * 256, L_END = L_OST + 8 * 4096;
constexpr float THR = 8.0f;
#define ATT_SBAR() __builtin_amdgcn_sched_barrier(0)
__device__ __forceinline__ int crow(int r, int hi) { return (r & 3) + 8 * (r >> 2) + 4 * hi; }

__device__ __forceinline__ void partialSM(f32x16& p0, f32x16& p1, float& m_reg, float& alpha) {
    float pmax = p0[0];
#pragma unroll
    for (int r = 1; r < 16; ++r) pmax = fmaxf(pmax, p0[r]);
#pragma unroll
    for (int r = 0; r < 16; ++r) pmax = fmaxf(pmax, p1[r]);
    { auto rr = __builtin_amdgcn_permlane32_swap(__float_as_uint(pmax), __float_as_uint(pmax), false, false); pmax = fmaxf(__uint_as_float(rr[0]), __uint_as_float(rr[1])); }
    float mn;
    if (__builtin_expect(__all(pmax - m_reg <= THR), 1)) { mn = m_reg; alpha = 1.f; }
    else { mn = fmaxf(m_reg, pmax); alpha = __builtin_amdgcn_exp2f(m_reg - mn); m_reg = mn; }
#pragma unroll
    for (int r = 0; r < 16; ++r) p0[r] -= mn;
#pragma unroll
    for (int r = 0; r < 16; ++r) p1[r] -= mn;
#pragma unroll
    for (int r = 0; r < 16; ++r) p0[r] = __builtin_amdgcn_exp2f(p0[r]);
}
__device__ __forceinline__ void finishSM(f32x16& p0, f32x16& p1, float alpha, float& l_reg, bf16x8& pa0, bf16x8& pa1, bf16x8& pa2, bf16x8& pa3) {
#pragma unroll
    for (int r = 0; r < 16; ++r) p1[r] = __builtin_amdgcn_exp2f(p1[r]);
    float ps = 0.f;
#pragma unroll
    for (int r = 0; r < 16; ++r) ps += p0[r];
#pragma unroll
    for (int r = 0; r < 16; ++r) ps += p1[r];
    { auto rr = __builtin_amdgcn_permlane32_swap(__float_as_uint(ps), __float_as_uint(ps), false, false); ps = __uint_as_float(rr[0]) + __uint_as_float(rr[1]); }
    l_reg = l_reg * alpha + ps;
#define ATT_PK4(P, BASE, OUT) do { const unsigned a0 = pk2(P[BASE + 0], P[BASE + 1]), a1 = pk2(P[BASE + 2], P[BASE + 3]), b0 = pk2(P[BASE + 4], P[BASE + 5]), b1 = pk2(P[BASE + 6], P[BASE + 7]); \
        auto r0 = __builtin_amdgcn_permlane32_swap(a0, b0, false, false); auto r1 = __builtin_amdgcn_permlane32_swap(a1, b1, false, false); \
        u32x4 w = {r0[0], r1[0], r0[1], r1[1]}; OUT = __builtin_bit_cast(bf16x8, w); } while (0)
    ATT_PK4(p0, 0, pa0); ATT_PK4(p0, 8, pa1); ATT_PK4(p1, 0, pa2); ATT_PK4(p1, 8, pa3);
#undef ATT_PK4
}
template <int DQK>
__device__ __forceinline__ void qkt(f32x16& p0, f32x16& p1, const LAS unsigned char* Kl, const bf16x8* qr, int r32, int hi) {
    p0 = f32x16{}; p1 = f32x16{};
#pragma unroll
    for (int d0 = 0; d0 < DQK / 16; ++d0) {
        const bf16x8 b0 = *(const LAS bf16x8*)(Kl + (2 * d0 + hi) * KCH + r32 * 16);
        const bf16x8 b1 = *(const LAS bf16x8*)(Kl + (2 * d0 + hi) * KCH + (32 + r32) * 16);
        p0 = __builtin_amdgcn_mfma_f32_32x32x16_bf16(b0, qr[d0], p0, 0, 0, 0);
        p1 = __builtin_amdgcn_mfma_f32_32x32x16_bf16(b1, qr[d0], p1, 0, 0, 0);
    }
}
__device__ __forceinline__ int v_st(int k, int c) { const int kk = (k & ~0xC) | ((k & 4) << 1) | ((k & 8) >> 1); return ((kk >> 3) * 2 + (c >> 5)) * 512 + ((kk & 7) * 32 + (c & 31)) * 2; }
__device__ __forceinline__ int v_rd_base(int lane) { return ((lane & 3) << 3) | (((lane >> 2) & 3) << 6) | (((lane >> 4) & 1) << 5) | (((lane >> 5) & 1) << 8); }
constexpr int v_rd_off(int d0, int ks, int half) { return d0 * 512 + ks * 2048 + half * 1024; }
template <int OFF> __device__ __forceinline__ s16x4 tr_read(int vb) { s16x4 r; asm volatile("ds_read_b64_tr_b16 %0, %1 offset:%2" : "=&v"(r) : "v"(vb), "i"(OFF) : "memory"); return r; }
template <int D0> __device__ __forceinline__ void pv_one(f32x16& od, int vb, bf16x8 pa0, bf16x8 pa1, bf16x8 pa2, bf16x8 pa3) {
    const s16x4 l0 = tr_read<v_rd_off(D0, 0, 0)>(vb), h0 = tr_read<v_rd_off(D0, 0, 1)>(vb), l1 = tr_read<v_rd_off(D0, 1, 0)>(vb), h1 = tr_read<v_rd_off(D0, 1, 1)>(vb);
    const s16x4 l2 = tr_read<v_rd_off(D0, 2, 0)>(vb), h2 = tr_read<v_rd_off(D0, 2, 1)>(vb), l3 = tr_read<v_rd_off(D0, 3, 0)>(vb), h3 = tr_read<v_rd_off(D0, 3, 1)>(vb);
    asm volatile("s_waitcnt lgkmcnt(0)" ::: "memory"); ATT_SBAR();
#define ATT_PK(L, H) (bf16x8){L[0], L[1], L[2], L[3], H[0], H[1], H[2], H[3]}
    od = __builtin_amdgcn_mfma_f32_32x32x16_bf16(pa0, ATT_PK(l0, h0), od, 0, 0, 0);
    od = __builtin_amdgcn_mfma_f32_32x32x16_bf16(pa1, ATT_PK(l1, h1), od, 0, 0, 0);
    od = __builtin_amdgcn_mfma_f32_32x32x16_bf16(pa2, ATT_PK(l2, h2), od, 0, 0, 0);
    od = __builtin_amdgcn_mfma_f32_32x32x16_bf16(pa3, ATT_PK(l3, h3), od, 0, 0, 0);
#undef ATT_PK
}
__device__ __forceinline__ void band_mask(f32x16& p0, f32x16& p1, int dq, int hi) {
#pragma unroll
    for (int r = 0; r < 16; ++r) { const int d0 = dq - crow(r, hi), d1 = d0 - 32;
        if (d0 > WINDOW || d0 < -WINDOW) p0[r] = -1e30f; if (d1 > WINDOW || d1 < -WINDOW) p1[r] = -1e30f; }
}

template <int DQK, bool WIN>
__device__ __forceinline__ void attn_unit(LAS unsigned char* lds, const bf16_t* __restrict__ Qb, int ldq, const bf16_t* __restrict__ Kh, int ldk, const bf16_t* __restrict__ Vh, int ldv,
                                          bf16_t* __restrict__ Ob, int NT, int qk0, float m0, float l0) {
    constexpr int NCH = DQK / 8, NPK = 64 * NCH;
    int tid_ = threadIdx.x; asm volatile("" : "+v"(tid_));
    const int tid = tid_, lane = tid & 63, r32 = lane & 31, hi = lane >> 5; const int wid = __builtin_amdgcn_readfirstlane(tid >> 6);
    LAS unsigned char* K_lds = lds + L_K; LAS unsigned char* V_lds = lds + L_V;
    LAS float* wsf = (LAS float*)(lds + L_WS) + wid * 64;
    float m_reg = m0, l_reg = l0; f32x16 o[2] = {}; bf16x8 qr[DQK / 16];
    const bf16_t* Qw = Qb + (size_t)(wid * 32 + r32) * ldq + hi * 8;
#pragma unroll
    for (int d0 = 0; d0 < DQK / 16; ++d0) qr[d0] = *(const bf16x8*)(Qw + d0 * 16);
    const int kk0 = tid / NCH, kc0 = tid % NCH, kk1 = (512 + tid) / NCH, kc1 = (512 + tid) % NCH;
    const bool two = (NPK > 512) && (tid < NPK - 512);
    const int kst0 = kc0 * KCH + kk0 * 16, kst1 = kc1 * KCH + kk1 * 16;
    const int vk = tid >> 3, vc = (tid & 7) * 8, vst = v_st(vk, vc);
    const int vb0 = (int)(uintptr_t)(V_lds) + v_rd_base(lane);
    struct { bf16x8 k0, k1, v; } sr_[2];
#define ATT_SLOAD(i, kb) do { sr_[i].k0 = *(const bf16x8*)(Kh + (size_t)((kb) + kk0) * ldk + kc0 * 8); if (two) sr_[i].k1 = *(const bf16x8*)(Kh + (size_t)((kb) + kk1) * ldk + kc1 * 8); \
        sr_[i].v = *(const bf16x8*)(Vh + (size_t)((kb) + vk) * ldv + vc); } while (0)
#define ATT_SWRITE(b, i) do { *(LAS bf16x8*)(K_lds + (b) * KBUF + kst0) = sr_[i].k0; if (two) *(LAS bf16x8*)(K_lds + (b) * KBUF + kst1) = sr_[i].k1; \
        *(LAS bf16x8*)(V_lds + (b) * VBUF + vst) = sr_[i].v; } while (0)
#define ATT_RESC(a) do { if (__any((a) < 1.f)) { if (hi == 0) wsf[r32] = (a); asm volatile("s_waitcnt lgkmcnt(0)" ::: "memory"); \
        _Pragma("unroll") for (int d = 0; d < 2; ++d) _Pragma("unroll") for (int r = 0; r < 16; ++r) o[d][r] *= wsf[crow(r, hi)]; } } while (0)
#define ATT_MASK(P0, P1, t) do { if (WIN) band_mask(P0, P1, qk0 + wid * 32 + r32 - (t) * 64, hi); } while (0)
    f32x16 pA0, pA1, pB0, pB1; float alA, alB; bf16x8 pa0, pa1, pa2, pa3;
    ATT_SLOAD(0, 0); asm volatile("s_waitcnt vmcnt(0)" ::: "memory"); ATT_SWRITE(0, 0); __syncthreads();
    qkt<DQK>(pA0, pA1, K_lds, qr, r32, hi); ATT_MASK(pA0, pA1, 0); partialSM(pA0, pA1, m_reg, alA);
    ATT_SLOAD(1, 64); if (2 < NT) ATT_SLOAD(0, 128);
    ATT_SWRITE(1, 1); __syncthreads();
    for (int j = 1; j + 1 < NT; j += 2) {
        ATT_SBAR(); qkt<DQK>(pB0, pB1, K_lds + KBUF, qr, r32, hi); ATT_MASK(pB0, pB1, j);
        finishSM(pA0, pA1, alA, l_reg, pa0, pa1, pa2, pa3); ATT_SBAR();
        ATT_SLOAD(1, (j + 2) * 64); ATT_SBAR();
        pv_one<0>(o[0], vb0, pa0, pa1, pa2, pa3); pv_one<1>(o[1], vb0, pa0, pa1, pa2, pa3); partialSM(pB0, pB1, m_reg, alB);
        __syncthreads(); ATT_SWRITE(0, 0);
        ATT_RESC(alB); __syncthreads();
        ATT_SBAR(); qkt<DQK>(pA0, pA1, K_lds, qr, r32, hi); ATT_MASK(pA0, pA1, j + 1);
        finishSM(pB0, pB1, alB, l_reg, pa0, pa1, pa2, pa3); ATT_SBAR();
        if (j + 3 < NT) ATT_SLOAD(0, (j + 3) * 64); ATT_SBAR();
        pv_one<0>(o[0], vb0 + VBUF, pa0, pa1, pa2, pa3); pv_one<1>(o[1], vb0 + VBUF, pa0, pa1, pa2, pa3); partialSM(pA0, pA1, m_reg, alA);
        __syncthreads(); ATT_SWRITE(1, 1);
        ATT_RESC(alA); __syncthreads();
    }
    ATT_SBAR(); qkt<DQK>(pB0, pB1, K_lds + KBUF, qr, r32, hi); ATT_MASK(pB0, pB1, NT - 1);
    finishSM(pA0, pA1, alA, l_reg, pa0, pa1, pa2, pa3); ATT_SBAR();
    pv_one<0>(o[0], vb0, pa0, pa1, pa2, pa3); pv_one<1>(o[1], vb0, pa0, pa1, pa2, pa3); partialSM(pB0, pB1, m_reg, alB);
    __syncthreads(); ATT_RESC(alB);
    finishSM(pB0, pB1, alB, l_reg, pa0, pa1, pa2, pa3); ATT_SBAR();
    pv_one<0>(o[0], vb0 + VBUF, pa0, pa1, pa2, pa3); pv_one<1>(o[1], vb0 + VBUF, pa0, pa1, pa2, pa3);
    if (hi == 0) wsf[32 + r32] = l_reg; asm volatile("s_waitcnt lgkmcnt(0)" ::: "memory");
    float rli[16];
#pragma unroll
    for (int r = 0; r < 16; ++r) rli[r] = __builtin_amdgcn_rcpf(wsf[32 + crow(r, hi)]);
    { LAS bf16_t* stg = (LAS bf16_t*)(lds + L_OST) + wid * 2048;
#pragma unroll
      for (int r = 0; r < 16; ++r) { const int orow = crow(r, hi);
#pragma unroll
        for (int d0 = 0; d0 < 2; ++d0) stg[orow * 64 + d0 * 32 + r32] = (bf16_t)(pk2(o[d0][r] * rli[r], 0.f) & 0xffffu); }
      asm volatile("s_waitcnt lgkmcnt(0)" ::: "memory");
      bf16_t* Ow = Ob + (size_t)(wid * 32) * DM;
#pragma unroll
      for (int i = 0; i < 4; ++i) { const int row = i * 8 + (lane >> 3), ch = lane & 7; const u32x4 v = *(const LAS u32x4*)(stg + row * 64 + ch * 8); *(u32x4*)(Ow + (size_t)row * DM + ch * 8) = v; } }
    __syncthreads();
#undef ATT_SLOAD
#undef ATT_SWRITE
#undef ATT_RESC
#undef ATT_MASK
}
#undef ATT_SBAR
}

template <int WHICH>
__device__ __forceinline__ void p0_transpose_item(const float* __restrict__ W, const float* __restrict__ W2, const float* __restrict__ gain, int K, int Nsrc, int NP, bf16_t* __restrict__ WT,
                                                  LAS float* scr, int item, int lane) {
    const int nblk = NP / 32, kb = item / nblk, nb = item % nblk, k0 = 64 * kb, n0 = 32 * nb;
    const int n = n0 + (lane & 31);
    const float* s = W; int c;
    if (WHICH == 3) { const int t = n >> 8, r = n & 255; if (r < 128) c = 128 * t + r; else { c = 128 * t + r - 128; s = W2; } }
    else if (WHICH == 0) c = map_win(n); else if (WHICH == 1) c = map_wuq(n); else c = n;
#pragma unroll 8
    for (int i = 0; i < 32; ++i) { const int kk = 2 * i + (lane >> 5); float v = 0.f; if (c >= 0) { v = s[(size_t)(k0 + kk) * Nsrc + c]; if (gain) v *= gain[k0 + kk]; } scr[kk * 33 + (lane & 31)] = v; }
    LDS_WAIT(); asm volatile("" ::: "memory");
    const int c8 = lane & 7;
#pragma unroll
    for (int j = 0; j < 4; ++j) { const int nn = (lane >> 3) + 8 * j; const LAS float* q = scr + (8 * c8) * 33 + nn;
        u32x4 o; o.x = pk2(q[0 * 33], q[1 * 33]); o.y = pk2(q[2 * 33], q[3 * 33]); o.z = pk2(q[4 * 33], q[5 * 33]); o.w = pk2(q[6 * 33], q[7 * 33]);
        *(u32x4*)(WT + (size_t)(n0 + nn) * K + k0 + 8 * c8) = o; }
    LDS_WAIT(); asm volatile("" ::: "memory");
}

#define XB_TMO      128
#define XB_XCNT(j)  (256  + 64 * (j))
#define XB_XSUB(j)  (1280 + 64 * (j))
#define XB_XGEN(j)  (2304 + 64 * (j))
#define XB_TOP      3328
#define XB_TOPGEN   3392
#define XCD_BAR_WORDS 3456
#define XB_SPIN_CAP (1u << 18)

__device__ __forceinline__ unsigned xb_ld(unsigned* p)              { return __hip_atomic_load(p, __ATOMIC_RELAXED, __HIP_MEMORY_SCOPE_AGENT); }
__device__ __forceinline__ unsigned xb_add(unsigned* p, unsigned v) { return __hip_atomic_fetch_add(p, v, __ATOMIC_RELAXED, __HIP_MEMORY_SCOPE_AGENT); }
__device__ __forceinline__ unsigned xb_xcc_id() { return (unsigned)__builtin_amdgcn_s_getreg((3 << 11) | 20) & 0xFu; }
#define XB_SPIN(cond, bar) do { unsigned _sp = 0; while (cond) { __builtin_amdgcn_s_sleep(1); \
    if ((++_sp & 255u) == 0u) { if (xb_ld(&(bar)[XB_TMO])) break; if (_sp > XB_SPIN_CAP) { atomicAdd(&(bar)[XB_TMO], 1u); break; } } } } while (0)

struct XcdBarrier {
    unsigned* bar; unsigned x;
    volatile LAS unsigned* st;
};

__device__ __forceinline__ XcdBarrier xcd_barrier_post(unsigned* bar, volatile LAS unsigned* st) {
    XcdBarrier b; b.bar = bar; b.x = xb_xcc_id(); b.st = st;
    if (threadIdx.x == 0) (void)xb_add(&bar[XB_XCNT(b.x)], 1u);
    return b;
}
__device__ __forceinline__ void xcd_barrier_complete(unsigned* bar, unsigned x, unsigned& nloc, unsigned& nx) {
    const unsigned G = gridDim.x * gridDim.y * gridDim.z;
    unsigned sum, cnt, mine, sp = 0u;
    for (;;) {
        sum = 0u; cnt = 0u; mine = 0u;
#pragma unroll
        for (unsigned j = 0; j < 16; ++j) { const unsigned c = xb_ld(&bar[XB_XCNT(j)]); sum += c; cnt += (c > 0u) ? 1u : 0u; mine = (j == x) ? c : mine; }
        if (sum == G) break;
        __builtin_amdgcn_s_sleep(1);
        if ((++sp & 255u) == 0u) { if (xb_ld(&bar[XB_TMO])) break; if (sp > XB_SPIN_CAP) { atomicAdd(&bar[XB_TMO], 1u); break; } }
    }
    nloc = mine > 0u ? mine : 1u; nx = cnt > 0u ? cnt : 1u;
}

__device__ __forceinline__ void xcd_barrier(const XcdBarrier& b) {
    asm volatile("s_waitcnt vmcnt(0)" ::: "memory");
    __syncthreads();
    if (threadIdx.x == 0) {
        unsigned* bar = b.bar;
        __builtin_amdgcn_s_waitcnt(0);
        unsigned nloc = b.st[0], nx = b.st[1];
        if (nloc == 0u) { xcd_barrier_complete(bar, b.x, nloc, nx); b.st[0] = nloc; b.st[1] = nx; }
        const unsigned old = xb_add(&bar[XB_XSUB(b.x)], 1u);
        const unsigned gen = old / nloc;
        if (old + 1u == (gen + 1u) * nloc) {
            __builtin_amdgcn_fence(__ATOMIC_RELEASE, "agent");
            asm volatile("s_waitcnt vmcnt(0)" ::: "memory");
            const unsigned og = xb_add(&bar[XB_TOP], 1u);
            const unsigned tg = og / nx;
            if (og + 1u == (tg + 1u) * nx) xb_add(&bar[XB_TOPGEN], 1u);
            else XB_SPIN(xb_ld(&bar[XB_TOPGEN]) == tg, bar);
            __builtin_amdgcn_fence(__ATOMIC_ACQUIRE, "agent");
            xb_add(&bar[XB_XGEN(b.x)], 1u);
            asm volatile("s_waitcnt vmcnt(0)" ::: "memory");
        } else {
            XB_SPIN(xb_ld(&bar[XB_XGEN(b.x)]) == gen, bar);
            __builtin_amdgcn_fence(__ATOMIC_ACQUIRE, "agent");
            asm volatile("s_waitcnt vmcnt(0)" ::: "memory");
        }
    }
    __syncthreads();
}

#ifndef PHMASK
#define PHMASK 0xFFFF
#endif
struct Args { const float* in[15]; float* out; unsigned char* ws; };

__global__ void __launch_bounds__(NTHREADS, 2) mega_fwd(Args args) {
    extern __shared__ __attribute__((aligned(16))) unsigned char lds_raw[];
    LAS unsigned char* lds = (LAS unsigned char*)lds_raw;
    cg::grid_group grid = cg::this_grid();
    const int tid = threadIdx.x, lane = tid & 63, wave = __builtin_amdgcn_readfirstlane(tid >> 6);
    const int G = gridDim.x, bx = blockIdx.x, vcu = (G % 8 == 0) ? (bx % 8) * (G / 8) + bx / 8 : bx;
    const int gw = vcu * NWAVES + wave, NGW = G * NWAVES;
    unsigned char* ws = args.ws;
    volatile LAS unsigned* MISC = (volatile LAS unsigned*)(lds + RING_BYTES);
    if (tid < 64) MISC[tid] = 0u;
    __syncthreads();
    XcdBarrier xbar = xcd_barrier_post((unsigned*)(ws + WS_CTL) + CW_BAR, MISC + 8);
    const float *xp = args.in[0], *xs = args.in[1], *g_mix = args.in[2], *w_in = args.in[3], *sink = args.in[4], *cq_g = args.in[5], *w_uq = args.in[6], *ckv_g = args.in[7], *w_ukv = args.in[8],
                *w_o = args.in[9], *g_ffn = args.in[10], *w_gate = args.in[11], *w_up = args.in[12], *w_down = args.in[13], *g_final = args.in[14];
    float* out = args.out;
    float *cosA = (float*)(ws + WS_COSA), *sinA = (float*)(ws + WS_SINA), *cosR = (float*)(ws + WS_COSR), *sinR = (float*)(ws + WS_SINR);
    float *rstd0 = (float*)(ws + WS_RSTD0), *SS = (float*)(ws + WS_SS);
    bf16_t *Wt_in = (bf16_t*)(ws + WS_WIN), *Wt_uq = (bf16_t*)(ws + WS_WUQ), *Wt_ukv = (bf16_t*)(ws + WS_WUKV), *Wt_o = (bf16_t*)(ws + WS_WO), *Wt_gu = (bf16_t*)(ws + WS_WGU), *Wt_down = (bf16_t*)(ws + WS_WDOWN);
    bf16_t *XB = (bf16_t*)(ws + WS_XB), *OB = (bf16_t*)(ws + WS_O), *QA = (bf16_t*)(ws + WS_QA), *KA = (bf16_t*)(ws + WS_KA), *VA = (bf16_t*)(ws + WS_VA), *CQ = (bf16_t*)(ws + WS_CQ), *CKV = (bf16_t*)(ws + WS_CKV);
    bf16_t *QB = (bf16_t*)(ws + WS_QB), *K96 = (bf16_t*)(ws + WS_K96), *VB = (bf16_t*)(ws + WS_VB), *H = (bf16_t*)(ws + WS_H), *ACT = (bf16_t*)(ws + WS_ACT);

    {
        LAS float* scr = (LAS float*)(lds + wave * 16384);
        constexpr int I_IN = (DM / 64) * (DINP / 32), I_UQ = (QRANK / 64) * (768 / 32), I_UKV = (KVRANK / 64) * (1024 / 32), I_O = (DM / 64) * (DM / 32), I_GU = (DM / 64) * (NGU / 32), I_DN = (DFF / 64) * (DM / 32);
        constexpr int NITEMS = I_IN + I_UQ + I_UKV + I_O + I_GU + I_DN;
        for (int it = gw; it < NITEMS; it += NGW) {
            int r = it;
            if (r < I_IN) { p0_transpose_item<0>(w_in, nullptr, g_mix, DM, DIN, DINP, Wt_in, scr, r, lane); continue; } r -= I_IN;
            if (r < I_UQ) { p0_transpose_item<1>(w_uq, nullptr, cq_g, QRANK, 768, 768, Wt_uq, scr, r, lane); continue; } r -= I_UQ;
            if (r < I_UKV) { p0_transpose_item<2>(w_ukv, nullptr, ckv_g, KVRANK, 1024, 1024, Wt_ukv, scr, r, lane); continue; } r -= I_UKV;
            if (r < I_O) { p0_transpose_item<2>(w_o, nullptr, nullptr, DM, DM, DM, Wt_o, scr, r, lane); continue; } r -= I_O;
            if (r < I_GU) { p0_transpose_item<3>(w_gate, w_up, g_ffn, DM, DFF, NGU, Wt_gu, scr, r, lane); continue; } r -= I_GU;
            p0_transpose_item<2>(w_down, nullptr, nullptr, DFF, DM, DM, Wt_down, scr, r, lane);
        }
        for (int i = (vcu * NTHREADS + tid); i < 8192 * 32; i += G * NTHREADS) {
            { const int pos = i >> 5, j = i & 31; const double inv = pow(10000.0, -(double)j / 32.0); const double a = (double)pos * inv; cosA[i] = (float)cos(a); sinA[i] = (float)sin(a); }
            if (i < 8192 * 16) { const int pos = i >> 4, j = i & 15; const double inv = pow(10000.0, -(double)j / 16.0); const double a = (double)pos * inv; cosR[i] = (float)cos(a); sinR[i] = (float)sin(a); }
        }
        for (int row = gw; row < M; row += NGW) {
            const float* xrow = row < MPROMPT ? xp + (size_t)row * DM : xs + (size_t)(row - MPROMPT) * DM;
            const f32x4* xr = (const f32x4*)xrow + lane;
            f32x4 v[4]; float s = 0.f;
#pragma unroll
            for (int j = 0; j < 4; ++j) { v[j] = xr[64 * j]; s += (v[j].x * v[j].x + v[j].y * v[j].y) + (v[j].z * v[j].z + v[j].w * v[j].w); }
            s = wave_sum(s);
            if (lane == 0) rstd0[row] = 1.0f / sqrtf(s * (1.0f / DM) + EPS);
            unsigned long long* o8 = (unsigned long long*)(XB + (size_t)row * DM) + lane;
#pragma unroll
            for (int j = 0; j < 4; ++j) o8[64 * j] = (unsigned long long)pk2(v[j].x, v[j].y) | ((unsigned long long)pk2(v[j].z, v[j].w) << 32);
        }
    }
    grid.sync();

#if PHMASK & 2
    { int kz = DM; asm volatile("" : "+s"(kz)); pg8::Gemm g{XB, Wt_in, M, DINP, kz}; pg8::StaticOrder S; S.init(M, DINP, G, bx);
      EpiRow8<EpiZ> E{{rstd0, cosA, sinA, cosR, sinR, QA, KA, VA, CQ, CKV, K96, SS}};
      pg8::gemm_phase<EpiRow8<EpiZ>, pg8::StaticOrder, true, true>(lds, g, S, E); }
#endif
    xcd_barrier(xbar);

#if PHMASK & 4
    { int kq = QRANK; asm volatile("" : "+s"(kq)); pg8::Gemm g{CQ, Wt_uq, M, 768, kq}; pg8::StaticOrder S; S.init(M, 768, G, bx);
      EpiRow8<EpiQ> E{{SS, cosR, sinR, QB}};
      pg8::gemm_phase<EpiRow8<EpiQ>, pg8::StaticOrder, true, true>(lds, g, S, E); }
#endif
#if PHMASK & 8
    { int kk = KVRANK; asm volatile("" : "+s"(kk)); pg8::Gemm g{CKV, Wt_ukv, M, 1024, kk}; pg8::StaticOrder S; S.init(M, 1024, G, bx);
      EpiRow8<EpiKV> E{{SS, K96, VB}};
      pg8::gemm_phase<EpiRow8<EpiKV>, pg8::StaticOrder, true, true>(lds, g, S, E); }
#endif
    xcd_barrier(xbar);

#if PHMASK & 16
#ifdef ATTN_NAIVE
    for (int it = bx; it < (M / 16) * HA; it += G) attn_naive_item<64, true>(lds, (it >> 3) * 16, it & 7, QA, 512, KA, 128, VA, 128, OB, 0, sink);
    for (int it = bx; it < (M / 16) * HB; it += G) attn_naive_item<96, false>(lds, (it >> 3) * 16, it & 7, QB, 768, K96, 768, VB, 512, OB, 512, nullptr);
#else
    for (int w = vcu; w < 12 * 256; w += G) {
        const int r = w >> 8, v = w & 255;
        if (r < 4) {
            const int bh = (v >> 5) * 4 + r, qb = v & 31, b = bh >> 3, h = bh & 7; const size_t q0 = (size_t)b * 8192 + qb * 256, sb = (size_t)b * 8192;
            att::attn_unit<96, false>(lds, QB + q0 * 768 + h * 96, 768, K96 + sb * 768 + h * 96, 768, VB + sb * 512 + h * 64, 512, OB + q0 * DM + 512 + h * 64, 128, 0, -1e30f, 0.f);
        } else if (r < 6) {
            const int idx = (v & 31) + 32 * (r - 4), bh = (v >> 5) * 4 + (idx >> 4), qb = idx & 15, b = bh >> 3, h = bh & 7; const size_t sb = (size_t)MPROMPT + (size_t)b * 4096, q0 = sb + qb * 256;
            att::attn_unit<96, false>(lds, QB + q0 * 768 + h * 96, 768, K96 + sb * 768 + h * 96, 768, VB + sb * 512 + h * 64, 512, OB + q0 * DM + 512 + h * 64, 64, 0, -1e30f, 0.f);
        } else {
            const int u = v * 6 + (r - 6), rb = u >> 3, h = u & 7, q0 = rb * 256; int t, sb, S; row_info(q0, t, sb, S);
            const int ks = max(sb, q0 - WINDOW), ke = min(sb + S, q0 + 256 + WINDOW);
            att::attn_unit<64, true>(lds, QA + (size_t)q0 * 512 + h * 64, 512, KA + (size_t)ks * 128 + (h >> 2) * 64, 128, VA + (size_t)ks * 128 + (h >> 2) * 64, 128, OB + (size_t)q0 * DM + h * 64,
                                     (ke - ks) >> 6, q0 - ks, sink[h] * LOG2E, 1.f);
        }
    }
#endif
#endif
    xcd_barrier(xbar);

#if PHMASK & 32
    { int ko = DM; asm volatile("" : "+s"(ko)); pg8::Gemm g{OB, Wt_o, M, DM, ko}; pg8::StaticOrder S; S.init(M, DM, G, bx);
      EpiRow8<EpiRes> E{{xp, xs, out}};
      pg8::gemm_phase<EpiRow8<EpiRes>, pg8::StaticOrder, true, true>(lds, g, S, E); }
#endif
    xcd_barrier(xbar);
    for (int row = gw; row < M; row += NGW) {
        const f32x4* xr = (const f32x4*)(out + (size_t)row * DM) + lane;
        f32x4 v[4]; float s = 0.f;
#pragma unroll
        for (int j = 0; j < 4; ++j) { v[j] = xr[64 * j]; s += (v[j].x * v[j].x + v[j].y * v[j].y) + (v[j].z * v[j].z + v[j].w * v[j].w); }
        const float r = 1.0f / sqrtf(wave_sum(s) * (1.0f / DM) + EPS);
        unsigned long long* o8 = (unsigned long long*)(H + (size_t)row * DM) + lane;
#pragma unroll
        for (int j = 0; j < 4; ++j) o8[64 * j] = (unsigned long long)pk2(v[j].x * r, v[j].y * r) | ((unsigned long long)pk2(v[j].z * r, v[j].w * r) << 32);
    }
    xcd_barrier(xbar);

#if PHMASK & 64
    { int kg = DM; asm volatile("" : "+s"(kg)); pg8::Gemm g{H, Wt_gu, M, NGU, kg}; pg8::StaticOrder S; S.init(M, NGU, G, bx);
      EpiDual8<EpiGU> E{{ACT}};
      pg8::gemm_phase<EpiDual8<EpiGU>, pg8::StaticOrder, true, true>(lds, g, S, E); }
#endif
    xcd_barrier(xbar);

#if PHMASK & 128
    { int kd = DFF; asm volatile("" : "+s"(kd)); pg8::Gemm g{ACT, Wt_down, M, DM, kd}; pg8::StaticOrder S; S.init(M, DM, G, bx);
      EpiRow8<EpiRes> E{{out, out + (size_t)MPROMPT * DM, out}};
      pg8::gemm_phase<EpiRow8<EpiRes>, pg8::StaticOrder, true, true>(lds, g, S, E); }
#endif
    xcd_barrier(xbar);

    for (int row = gw; row < M; row += NGW) {
        f32x4* xr = (f32x4*)(out + (size_t)row * DM) + lane; const f32x4* gr = (const f32x4*)g_final + lane;
        f32x4 v[4]; float s = 0.f;
#pragma unroll
        for (int j = 0; j < 4; ++j) { v[j] = xr[64 * j]; s += (v[j].x * v[j].x + v[j].y * v[j].y) + (v[j].z * v[j].z + v[j].w * v[j].w); }
        const float r = 1.0f / sqrtf(wave_sum(s) * (1.0f / DM) + EPS);
#pragma unroll
        for (int j = 0; j < 4; ++j) xr[64 * j] = v[j] * r * gr[64 * j];
    }
}

extern "C" void kernel_launch(void* const* d_in, const int* in_sizes, int n_in, void* d_out, int out_size, void* d_ws, size_t ws_size, hipStream_t stream) {
    static int grid = 0;
    if (grid == 0) {
        if (n_in != 15 || in_sizes[0] != MPROMPT * DM || in_sizes[1] != (M - MPROMPT) * DM || out_size != M * DM || ws_size < WS_END) {
            fprintf(stderr, "kernel_launch: unexpected shapes: n_in %d in0 %d in1 %d out %d ws %zu (need %zu)\n", n_in, n_in > 0 ? in_sizes[0] : -1, n_in > 1 ? in_sizes[1] : -1, out_size, ws_size, (size_t)WS_END);
            grid = -1; return;
        }
        int dev = 0, cus = 0, per_cu = 0;
        if (hipGetDevice(&dev) != hipSuccess || hipDeviceGetAttribute(&cus, hipDeviceAttributeMultiprocessorCount, dev) != hipSuccess) { fprintf(stderr, "kernel_launch: device query failed\n"); grid = -1; return; }
        if (hipFuncSetAttribute((const void*)mega_fwd, hipFuncAttributeMaxDynamicSharedMemorySize, LDS_BYTES) != hipSuccess) { fprintf(stderr, "kernel_launch: hipFuncSetAttribute failed\n"); grid = -1; return; }
        if (hipOccupancyMaxActiveBlocksPerMultiprocessor(&per_cu, (const void*)mega_fwd, NTHREADS, LDS_BYTES) != hipSuccess || per_cu < 1) { fprintf(stderr, "kernel_launch: occupancy query says %d blocks per CU\n", per_cu); grid = -1; return; }
        grid = cus;
    }
    if (grid < 0) return;
    if (hipMemsetAsync((char*)d_ws + WS_CTL, 0, CTL_ZERO_BYTES, stream) != hipSuccess) { fprintf(stderr, "kernel_launch: hipMemsetAsync failed\n"); return; }
    Args a{};
    for (int i = 0; i < 15; ++i) a.in[i] = (const float*)d_in[i];
    a.out = (float*)d_out; a.ws = (unsigned char*)d_ws;
    void* kargs[] = {&a};
    const hipError_t e = hipLaunchCooperativeKernel((const void*)mega_fwd, dim3(grid), dim3(NTHREADS), kargs, LDS_BYTES, stream);
    if (e != hipSuccess) fprintf(stderr, "kernel_launch: cooperative launch failed: %s (grid %d)\n", hipGetErrorString(e), grid);
}
```
